# Optimizing an MI355X kernel written in HIP

```python
import math
import jax, jax.numpy as jnp
from jax import lax
import numpy as np

D_MODEL = 1024
BATCH = 4
SEQ = 8192
DEPTH = 2

N_A = DEPTH // 2
N_B = DEPTH - N_A
CHUNK = 128
D_GATE = D_MODEL
N_GROUPS = 8
GROUP_DIM = D_GATE // N_GROUPS
N_HEADS = 8
HEAD_DIM = 64
V_DIM = 2 * HEAD_DIM
QK_WIDTH = N_HEADS * 2 * HEAD_DIM
V_WIDTH = N_HEADS * V_DIM
Q_BLOCK = 128
D_FF = int(math.ceil(8 * D_MODEL / 3 / 256) * 256)
EPS = 1e-6

kernel_name = "yoco_gmlp_diffattn_alibi_swiglu"


def _alibi_slopes(n):
    return np.array([2.0 ** (-8.0 * (i + 1) / n) for i in range(n)], dtype=np.float32)


def _lambda_init(layer_idx):
    return 0.8 - 0.6 * math.exp(-0.3 * layer_idx)


def rms_norm(x, g):
    xf = x.astype(jnp.float32)
    y = xf * lax.rsqrt(jnp.mean(xf * xf, axis=-1, keepdims=True) + EPS)
    return (y * g.astype(jnp.float32)).astype(x.dtype)


def layer_norm_gain(x, g):
    xf = x.astype(jnp.float32)
    mu = jnp.mean(xf, axis=-1, keepdims=True)
    var = jnp.mean(jnp.square(xf - mu), axis=-1, keepdims=True)
    return ((xf - mu) * lax.rsqrt(var + EPS) * g.astype(jnp.float32)).astype(x.dtype)


def swiglu(h, w_gu, w_down):
    gu = h @ w_gu
    g, u = jnp.split(gu, 2, axis=-1)
    return (jax.nn.silu(g) * u) @ w_down


def gmlp_mixer(h, w_in, v_gain, w_sp, b_sp, w_out):
    B, S, _ = h.shape
    uv = jax.nn.gelu(h @ w_in)
    u, v = jnp.split(uv, 2, axis=-1)
    v = layer_norm_gain(v, v_gain)
    v = v.reshape(B, S // CHUNK, CHUNK, N_GROUPS, GROUP_DIM)
    causal = jnp.tril(jnp.ones((CHUNK, CHUNK), dtype=w_sp.dtype))
    z = jnp.einsum('gts,bcsgd->bctgd', w_sp * causal, v)
    z = z + b_sp.T[None, None, :, :, None]
    return (u * z.reshape(B, S, D_GATE)) @ w_out


def shared_kv(x, g, w_kv):
    B, S, _ = x.shape
    kv = rms_norm(x, g) @ w_kv
    k = kv[..., :QK_WIDTH].reshape(B, S, N_HEADS, 2, HEAD_DIM).transpose(0, 2, 3, 1, 4)
    v = kv[..., QK_WIDTH:].reshape(B, S, N_HEADS, V_DIM).transpose(0, 2, 1, 3)
    return k, v


def diff_attention(h, k, v, w_q, lam_vecs, subln, w_o, lambda_init):
    B, S, _ = h.shape
    n_blk = S // Q_BLOCK
    q = (h @ w_q).reshape(B, S, N_HEADS, 2, HEAD_DIM)
    q = q.reshape(B, n_blk, Q_BLOCK, N_HEADS, 2, HEAD_DIM).transpose(1, 0, 3, 4, 2, 5)
    lf = lam_vecs.astype(jnp.float32)
    lam = jnp.exp(jnp.sum(lf[0] * lf[1])) - jnp.exp(jnp.sum(lf[2] * lf[3])) + lambda_init
    slopes = jnp.asarray(_alibi_slopes(N_HEADS))
    scale = HEAD_DIM ** -0.5
    kf = k.astype(jnp.float32)
    vf = v.astype(jnp.float32)
    key_pos = jnp.arange(S, dtype=jnp.int32)

    def block(args):
        qb, bi = args
        q_pos = bi * Q_BLOCK + jnp.arange(Q_BLOCK, dtype=jnp.int32)
        dist = (q_pos[:, None] - key_pos[None, :]).astype(jnp.float32)
        bias = -slopes[:, None, None] * dist[None]
        s = jnp.einsum('bhitd,bhisd->bhits', qb.astype(jnp.float32), kf) * scale
        s = s + bias[None, :, None]
        s = jnp.where((dist >= 0)[None, None, None], s, -jnp.inf)
        p = jax.nn.softmax(s, axis=-1)
        a = p[:, :, 0] - lam * p[:, :, 1]
        return jnp.einsum('bhts,bhsd->bhtd', a, vf)

    o = lax.map(block, (q, jnp.arange(n_blk, dtype=jnp.int32)))
    o = o.transpose(1, 0, 3, 2, 4).reshape(B, S, N_HEADS, V_DIM).astype(h.dtype)
    o = rms_norm(o, subln) * (1.0 - lambda_init)
    return o.reshape(B, S, V_WIDTH) @ w_o


def setup_inputs(seed: int = 0) -> dict:
    key = jax.random.key(seed)
    ks = jax.random.split(key, 20)
    f32 = jnp.float32

    def w(k, shape, fan_in):
        return jax.random.normal(k, shape, f32) * (fan_in ** -0.5)

    def gain(k, shape):
        return 1.0 + 0.05 * jax.random.normal(k, shape, f32)

    return {
        "x": jax.random.normal(ks[0], (BATCH, SEQ, D_MODEL), f32),
        "a_norm": gain(ks[1], (N_A, D_MODEL)),
        "a_w_in": w(ks[2], (N_A, D_MODEL, 2 * D_GATE), D_MODEL),
        "a_v_norm": gain(ks[3], (N_A, D_GATE)),
        "a_w_sp": w(ks[4], (N_A, N_GROUPS, CHUNK, CHUNK), CHUNK),
        "a_b_sp": 1.0 + 0.1 * jax.random.normal(ks[5], (N_A, N_GROUPS, CHUNK), f32),
        "a_w_out": w(ks[6], (N_A, D_GATE, D_MODEL), D_GATE),
        "ffn_norm": gain(ks[7], (DEPTH, D_MODEL)),
        "ffn_w_gu": w(ks[8], (DEPTH, D_MODEL, 2 * D_FF), D_MODEL),
        "ffn_w_down": w(ks[9], (DEPTH, D_FF, D_MODEL), D_FF),
        "kv_norm": gain(ks[10], (D_MODEL,)),
        "kv_w": w(ks[11], (D_MODEL, QK_WIDTH + V_WIDTH), D_MODEL),
        "b_norm": gain(ks[12], (N_B, D_MODEL)),
        "b_w_q": w(ks[13], (N_B, D_MODEL, QK_WIDTH), D_MODEL),
        "b_lambda": 0.1 * jax.random.normal(ks[14], (N_B, 4, HEAD_DIM), f32),
        "b_subln": gain(ks[15], (N_B, V_DIM)),
        "b_w_o": w(ks[16], (N_B, V_WIDTH, D_MODEL), V_WIDTH),
        "final_norm": gain(ks[17], (D_MODEL,)),
    }


def reference(x, a_norm, a_w_in, a_v_norm, a_w_sp, a_b_sp, a_w_out, ffn_norm, ffn_w_gu, ffn_w_down,
              kv_norm, kv_w, b_norm, b_w_q, b_lambda, b_subln, b_w_o, final_norm):
    k = v = None
    for l in range(DEPTH):
        if l < N_A:
            x = x + gmlp_mixer(rms_norm(x, a_norm[l]), a_w_in[l], a_v_norm[l],
                               a_w_sp[l], a_b_sp[l], a_w_out[l])
        else:
            j = l - N_A
            if j == 0:
                k, v = shared_kv(x, kv_norm, kv_w)
            x = x + diff_attention(rms_norm(x, b_norm[j]), k, v, b_w_q[j], b_lambda[j],
                                   b_subln[j], b_w_o[j], _lambda_init(l))
        x = x + swiglu(rms_norm(x, ffn_norm[l]), ffn_w_gu[l], ffn_w_down[l])
    return rms_norm(x, final_norm)
```

```cpp
#include <hip/hip_runtime.h>
#include <hip/hip_cooperative_groups.h>
#include <cstdio>
#include <cstdint>
namespace cg = cooperative_groups;
namespace pg8 {
#define PG8_LAS __attribute__((address_space(3)))
typedef unsigned short bf16_t;
typedef short bf16x8 __attribute__((ext_vector_type(8)));
typedef float f32x4 __attribute__((ext_vector_type(4)));
typedef unsigned u32x4 __attribute__((ext_vector_type(4)));
constexpr int BM = 256, BK = 64, HALF = 128, HTB = HALF * BK * 2  , STAGE_BYTES = 8 * HTB, NXCD = 8, WGM = 8;

__host__ __device__ __forceinline__ int lds_byte(int r, int c) { const int st = (r >> 4) * 2 + (c >> 5), rr = r & 15, cc = c & 31, ob = rr * 64 + cc * 2; return st * 1024 + (ob ^ (((ob >> 9) & 1) << 5)); }
__host__ __device__ __forceinline__ void stage_rc(int b, int& R, int& C) { const int st = b / 1024, sb = b % 1024, swz = sb ^ (((sb >> 9) & 1) << 5); R = (st >> 1) * 16 + swz / 64; C = (st & 1) * 32 + (swz % 64) / 2; }
__host__ __device__ __forceinline__ int perm32(int rho) { const int n = rho >> 4, i = rho & 15; return 8 * (i >> 2) + 4 * n + (i & 3); }

struct Unit { int pm, pn; };
struct Gemm { const bf16_t* A; const bf16_t* Bt; int M, N, K; };

struct StaticOrder {
    int nM, nN, nwg, G, c;
    __host__ __device__ void init(int M, int N, int G_, int c_) { nM = M / BM; nN = N / BM; nwg = nM * nN; G = G_; c = c_; }
    __host__ __device__ bool next(int i, Unit& u) const {
        const long L = (long)i * G + c; if (L >= nwg) return false;
        int wgid = (int)L; { const int q = nwg / NXCD, r = nwg % NXCD, xcd = wgid % NXCD, off = wgid / NXCD; wgid = (xcd < r ? xcd * (q + 1) : r * (q + 1) + (xcd - r) * q) + off; }
        const int nig = WGM * nN, gid = wgid / nig, fm = gid * WGM, gsz = (nM - fm) < WGM ? (nM - fm) : WGM;
        u.pm = fm + ((wgid % nig) % gsz); u.pn = (wgid % nig) / gsz; return true;
    }
    __device__ __forceinline__ void a_ready(const Unit&) const {}
    __device__ __forceinline__ void done(const Unit&) const {}
};

typedef float f32x2 __attribute__((ext_vector_type(2)));
typedef unsigned u32x2 __attribute__((ext_vector_type(2)));
__device__ __forceinline__ unsigned cvt_pk_bf16(float lo, float hi) { typedef __bf16 b2 __attribute__((ext_vector_type(2))); f32x2 v = {lo, hi}; b2 b = __builtin_convertvector(v, b2); return __builtin_bit_cast(unsigned, b); }
constexpr int DM = 1024;
constexpr size_t SSM = 32768;
constexpr float NORM_EPS = 1e-6f;
__device__ __forceinline__ void load_rstd(const float* ss, const Unit& u, int wr, int fr, int fq, float (&rs)[2][4]) {
#pragma unroll
    for (int ai = 0; ai < 2; ++ai)
#pragma unroll
        for (int m = 0; m < 4; ++m) { const int row = u.pm * BM + ai * HALF + wr * 64 + m * 16 + fr;
            float s = ss[(size_t)fq * SSM + row];
            s += __shfl_xor(s, 16); s += __shfl_xor(s, 32); rs[ai][m] = rsqrtf(s * (1.0f / DM) + NORM_EPS); }
}
__device__ __forceinline__ float gelu_tanh(float x) { const float t = x * (1.0f + 0.044715f * x * x); const float e = __builtin_amdgcn_exp2f(-2.302208198f * t); return x * __builtin_amdgcn_rcpf(1.0f + e); }
__device__ __forceinline__ float silu_f(float x) { const float e = __builtin_amdgcn_exp2f(-1.4426950408889634f * x); return x * __builtin_amdgcn_rcpf(1.0f + e); }

struct EpiGeluSplit {
    static constexpr bool PERM = true, AFTER_DRAIN = false, SWAP = false;
    bf16_t* O0; bf16_t* O1; const float* ss; int act;
    unsigned* kn;
    __device__ __forceinline__ void operator()(const f32x4 (&acc)[2][2][4][2], const Unit& u, int wr, int wc, int fr, int fq) const {
        float rs[2][4]; load_rstd(ss, u, wr, fr, fq, rs);
        bf16_t* base = (u.pn < 4) ? O0 : O1; const int col0 = (u.pn & 3) * BM + wc * 32 + 8 * fq;
        const bool dokn = (kn != nullptr) && (u.pn >= 4); float knm[2] = {0.f, 0.f};
#pragma unroll
        for (int ai = 0; ai < 2; ++ai)
#pragma unroll
            for (int m = 0; m < 4; ++m) { const int row = u.pm * BM + ai * HALF + wr * 64 + m * 16 + fr; const float r = rs[ai][m]; bf16_t* rowp = base + (size_t)row * DM + col0;
#pragma unroll
                for (int bj = 0; bj < 2; ++bj) { f32x4 v0 = acc[ai][bj][m][0] * r, v1 = acc[ai][bj][m][1] * r;
                    if (act) {
#pragma unroll
                        for (int e = 0; e < 4; ++e) { v0[e] = gelu_tanh(v0[e]); v1[e] = gelu_tanh(v1[e]); } }
                    u32x4 w; w.x = cvt_pk_bf16(v0[0], v0[1]); w.y = cvt_pk_bf16(v0[2], v0[3]); w.z = cvt_pk_bf16(v1[0], v1[1]); w.w = cvt_pk_bf16(v1[2], v1[3]);
                    *(u32x4*)(rowp + bj * HALF) = w;
                    if (dokn) { float q = 0.f;
#pragma unroll
                        for (int e = 0; e < 4; ++e) { const float lo = __builtin_bit_cast(float, w[e] << 16), hi = __builtin_bit_cast(float, w[e] & 0xffff0000u); q += lo * lo + hi * hi; }
                        q += __shfl_xor(q, 16); q += __shfl_xor(q, 32); knm[bj] = fmaxf(knm[bj], q); } } }
        if (dokn) {
#pragma unroll
            for (int bj = 0; bj < 2; ++bj) { float q = knm[bj]; q = fmaxf(q, __shfl_xor(q, 1)); q = fmaxf(q, __shfl_xor(q, 2)); q = fmaxf(q, __shfl_xor(q, 4)); q = fmaxf(q, __shfl_xor(q, 8));
                if (fr == 0 && fq == 0) { const int b = u.pm >> 5, h = 2 * (u.pn & 3) + bj;
                    __hip_atomic_fetch_max(kn + ((b * 8 + h) * 2 + (wc >> 1)) * 2 + (wc & 1), __builtin_bit_cast(unsigned, q), __ATOMIC_RELAXED, __HIP_MEMORY_SCOPE_AGENT); } } }
    }
};
struct EpiSwiglu {
    static constexpr bool PERM = true, AFTER_DRAIN = false, SWAP = false;
    bf16_t* O; int ldo; const float* ss;
    __device__ __forceinline__ void operator()(const f32x4 (&acc)[2][2][4][2], const Unit& u, int wr, int wc, int fr, int fq) const {
        float rs[2][4]; load_rstd(ss, u, wr, fr, fq, rs);
        const int col0 = u.pn * HALF + wc * 32 + 8 * fq;
#pragma unroll
        for (int ai = 0; ai < 2; ++ai)
#pragma unroll
            for (int m = 0; m < 4; ++m) { const int row = u.pm * BM + ai * HALF + wr * 64 + m * 16 + fr; const float r = rs[ai][m];
                float o[8];
#pragma unroll
                for (int n = 0; n < 2; ++n)
#pragma unroll
                    for (int e = 0; e < 4; ++e) { const float g = acc[ai][0][m][n][e] * r, uu = acc[ai][1][m][n][e] * r; o[n * 4 + e] = silu_f(g) * uu; }
                u32x4 w; w.x = cvt_pk_bf16(o[0], o[1]); w.y = cvt_pk_bf16(o[2], o[3]); w.z = cvt_pk_bf16(o[4], o[5]); w.w = cvt_pk_bf16(o[6], o[7]);
                *(u32x4*)(O + (size_t)row * ldo + col0) = w; }
    }
};
struct EpiVT {
    static constexpr bool PERM = false, AFTER_DRAIN = false, SWAP = true;
    bf16_t* VT; const float* ss;
    __device__ __forceinline__ void operator()(const f32x4 (&acc)[2][2][4][2], const Unit& u, int wr, int wc, int fr, int fq) const {
        float rs[2][4]; load_rstd(ss, u, wr, fr, fq, rs);
        const int b = u.pm >> 5;
#pragma unroll
        for (int ai = 0; ai < 2; ++ai)
#pragma unroll
            for (int m = 0; m < 4; ++m) {
                float rt[4];
#pragma unroll
                for (int e = 0; e < 4; ++e) rt[e] = __shfl(rs[ai][m], 4 * fq + e);
                const int s0 = (u.pm & 31) * BM + ai * HALF + wr * 64 + m * 16 + 4 * (((fq & 1) << 1) | (fq >> 1));
#pragma unroll
                for (int bj = 0; bj < 2; ++bj)
#pragma unroll
                    for (int n = 0; n < 2; ++n) { const int h = 2 * u.pn + bj, d = wc * 32 + 16 * n + fr; const f32x4 v = acc[ai][bj][m][n];
                        u32x2 w; w.x = cvt_pk_bf16(v[0] * rt[0], v[1] * rt[1]); w.y = cvt_pk_bf16(v[2] * rt[2], v[3] * rt[3]);
                        *(u32x2*)(VT + ((size_t)((b * 8 + h) * 128 + d)) * 8192 + s0) = w; } }
    }
};
template <bool FINAL> struct EpiRes {
    static constexpr bool PERM = true, AFTER_DRAIN = false, SWAP = false;
    bf16_t* xb; float* outf; float* ssout; PG8_LAS float* part;
    __device__ __forceinline__ void operator()(const f32x4 (&acc)[2][2][4][2], const Unit& u, int wr, int wc, int fr, int fq) const {
        const int col0 = u.pn * BM + wc * 32 + 8 * fq;
#pragma unroll
        for (int ai = 0; ai < 2; ++ai) {
            u32x4 bw[4][2]; float qv[4];
#pragma unroll
            for (int m = 0; m < 4; ++m)
#pragma unroll
                for (int bj = 0; bj < 2; ++bj) bw[m][bj] = *(const u32x4*)(xb + (size_t)(u.pm * BM + ai * HALF + wr * 64 + m * 16 + fr) * DM + col0 + bj * HALF);
#pragma unroll
            for (int m = 0; m < 4; ++m) { const int row = u.pm * BM + ai * HALF + wr * 64 + m * 16 + fr; const size_t off = (size_t)row * DM + col0; float q = 0.f;
#pragma unroll
                for (int bj = 0; bj < 2; ++bj) { const u32x4 b = bw[m][bj]; f32x4 v0 = acc[ai][bj][m][0], v1 = acc[ai][bj][m][1];
                    v0[0] += __builtin_bit_cast(float, b.x << 16); v0[1] += __builtin_bit_cast(float, b.x & 0xffff0000u); v0[2] += __builtin_bit_cast(float, b.y << 16); v0[3] += __builtin_bit_cast(float, b.y & 0xffff0000u);
                    v1[0] += __builtin_bit_cast(float, b.z << 16); v1[1] += __builtin_bit_cast(float, b.z & 0xffff0000u); v1[2] += __builtin_bit_cast(float, b.w << 16); v1[3] += __builtin_bit_cast(float, b.w & 0xffff0000u);
                    if (FINAL) { *(f32x4*)(outf + off + bj * HALF) = v0; *(f32x4*)(outf + off + bj * HALF + 4) = v1; }
                    else { u32x4 w; w.x = cvt_pk_bf16(v0[0], v0[1]); w.y = cvt_pk_bf16(v0[2], v0[3]); w.z = cvt_pk_bf16(v1[0], v1[1]); w.w = cvt_pk_bf16(v1[2], v1[3]); *(u32x4*)(xb + off + bj * HALF) = w; }
                    q += ((v0[0] * v0[0] + v0[1] * v0[1]) + (v0[2] * v0[2] + v0[3] * v0[3])) + ((v1[0] * v1[0] + v1[1] * v1[1]) + (v1[2] * v1[2] + v1[3] * v1[3])); }
                q += __shfl_xor(q, 16); q += __shfl_xor(q, 32); qv[m] = q; }
            const float qs = (fq == 0) ? qv[0] : (fq == 1) ? qv[1] : (fq == 2) ? qv[2] : qv[3];
            part[(wr * 4 + wc) * 128 + ai * 64 + 16 * fq + fr] = qs; }
        asm volatile("s_waitcnt lgkmcnt(0)" ::: "memory"); __builtin_amdgcn_s_barrier(); asm volatile("" ::: "memory");
        if (fq < 2) { const int idx = wc * 32 + fq * 16 + fr; const PG8_LAS float* pp = part + wr * 512 + idx;
            const float s = (pp[0] + pp[128]) + (pp[256] + pp[384]);
            ssout[(size_t)u.pn * SSM + (u.pm * BM + (idx >> 6) * HALF + wr * 64 + (idx & 63))] = s; }
    }
};
template <class Epi, class Sched, bool ALIGN_EPI = false, bool SP2 = false>
__device__ __forceinline__ void gemm_phase(PG8_LAS unsigned char* lds, const Gemm g, const Sched& S, const Epi& E) {
    const int tid = threadIdx.x, wid = __builtin_amdgcn_readfirstlane(tid >> 6), lane = tid & 63, wr = wid >> 2, wc = wid & 3, fr = lane & 15, fq = lane >> 4;
    const int K = g.K, nt = K / BK;
    unsigned voffA[2], voffB[2];
#pragma unroll
    for (int i = 0; i < 2; ++i) { int R, C; stage_rc(tid * 16 + i * 8192, R, C); const int Rb = Epi::PERM ? ((R & ~31) + perm32(R & 31)) : R;
        voffA[i] = (unsigned)(R * K + C) * 2u; voffB[i] = (unsigned)(Rb * K + C) * 2u; }
    const size_t kstep = (size_t)(BK * 2);
    const size_t hstep = (size_t)HALF * K * 2;
    const size_t tstep = 2 * hstep;
    const unsigned ldsw = (unsigned)wid * 1024u;
    const int aoff = lds_byte(wr * 64 + fr, fq * 8), boff = lds_byte(wc * 32 + fr, fq * 8);
#define PG8_SA(b, h) (((b) * 2 + (h)) * HTB)
#define PG8_SB(b, h) ((4 + (b) * 2 + (h)) * HTB)
#define PG8_STAGE(bufoff, gbase, voff) do { _Pragma("unroll") for (int _i = 0; _i < 2; ++_i) \
        __builtin_amdgcn_global_load_lds((const unsigned*)((const char*)(gbase) + (voff)[_i]), (PG8_LAS unsigned*)(lds + (bufoff) + ldsw + _i * 8192), 16, 0, 0); } while (0)
#define PG8_LDA(dst, b, h) do { _Pragma("unroll") for (int m = 0; m < 4; ++m) _Pragma("unroll") for (int k = 0; k < 2; ++k) dst[m][k] = *(const PG8_LAS bf16x8*)(lds + PG8_SA(b, h) + aoff + m * 2048 + k * 1024); } while (0)
#define PG8_LDB(dst, b, h) do { _Pragma("unroll") for (int n = 0; n < 2; ++n) _Pragma("unroll") for (int k = 0; k < 2; ++k) dst[n][k] = *(const PG8_LAS bf16x8*)(lds + PG8_SB(b, h) + boff + n * 2048 + k * 1024); } while (0)
#define PG8_MMA(ai, bj, At, Bt) do { __builtin_amdgcn_s_setprio(1); _Pragma("unroll") for (int m = 0; m < 4; ++m) _Pragma("unroll") for (int n = 0; n < 2; ++n) _Pragma("unroll") for (int k = 0; k < 2; ++k) \
        acc[ai][bj][m][n] = Epi::SWAP ? __builtin_amdgcn_mfma_f32_16x16x32_bf16(At[m][k], Bt[n][k], acc[ai][bj][m][n], 0, 0, 0) : __builtin_amdgcn_mfma_f32_16x16x32_bf16(Bt[n][k], At[m][k], acc[ai][bj][m][n], 0, 0, 0); __builtin_amdgcn_s_setprio(0); } while (0)
#define PG8_WAIT_V(n) asm volatile("s_waitcnt vmcnt(" #n ")" ::: "memory")
#define PG8_WAIT_L(n) asm volatile("s_waitcnt lgkmcnt(" #n ")" ::: "memory")
#define PG8_BAR __builtin_amdgcn_s_barrier()
#define PG8_SCHED __builtin_amdgcn_sched_barrier(0)
    Unit cur, nxt; int ui = 0;
    if (!S.next(0, cur)) return;
    f32x4 acc[2][2][4][2];
#pragma unroll
    for (int a = 0; a < 2; ++a)
#pragma unroll
        for (int b = 0; b < 2; ++b)
#pragma unroll
            for (int m = 0; m < 4; ++m)
#pragma unroll
                for (int n = 0; n < 2; ++n) acc[a][b][m][n] = (f32x4){0.f, 0.f, 0.f, 0.f};
    bf16x8 At[4][2], B0[2][2], B1[2][2];
    const char* cA = (const char*)g.A + (size_t)cur.pm * tstep; const char* cB = (const char*)g.Bt + (size_t)cur.pn * tstep;
    S.a_ready(cur);
    if constexpr (SP2) {
        PG8_STAGE(PG8_SB(0, 0), cB, voffB); PG8_STAGE(PG8_SB(0, 1), cB + hstep, voffB); PG8_STAGE(PG8_SA(0, 0), cA, voffA); PG8_STAGE(PG8_SA(0, 1), cA + hstep, voffA);
        if (wr == 1) PG8_BAR;
        PG8_WAIT_V(2); PG8_BAR;
        PG8_STAGE(PG8_SB(1, 0), cB + kstep, voffB); PG8_STAGE(PG8_SA(1, 0), cA + kstep, voffA); PG8_STAGE(PG8_SB(1, 1), cB + hstep + kstep, voffB);
        PG8_WAIT_V(6); PG8_BAR;
    } else {
        PG8_STAGE(PG8_SB(0, 0), cB, voffB); PG8_STAGE(PG8_SA(0, 0), cA, voffA); PG8_STAGE(PG8_SB(0, 1), cB + hstep, voffB); PG8_STAGE(PG8_SA(0, 1), cA + hstep, voffA);
        if (wr == 1) PG8_BAR;
        PG8_WAIT_V(4); PG8_BAR;
        PG8_STAGE(PG8_SB(1, 0), cB + kstep, voffB); PG8_STAGE(PG8_SA(1, 0), cA + kstep, voffA); PG8_STAGE(PG8_SB(1, 1), cB + hstep + kstep, voffB);
        PG8_WAIT_V(6); PG8_BAR;
    }
    for (;;) {
        const bool has_next = S.next(ui + 1, nxt);
        const char* nA = has_next ? (const char*)g.A + (size_t)nxt.pm * tstep : cA; const char* nB = has_next ? (const char*)g.Bt + (size_t)nxt.pn * tstep : cB;
        for (int t = 0; t < nt; t += 2) {
            const bool last = (t == nt - 2);
            const char* a1 = cA + (size_t)(t + 1) * kstep;
            const char* a2 = last ? nA : cA + (size_t)(t + 2) * kstep; const char* b2 = last ? nB : cB + (size_t)(t + 2) * kstep;
            const char* a3 = a2 + kstep; const char* b3 = b2 + kstep;
            if (last && has_next) S.a_ready(nxt);
            if constexpr (SP2) {
            PG8_LDB(B0, 0, 0); PG8_LDB(B1, 0, 1); PG8_SCHED; PG8_LDA(At, 0, 0); PG8_STAGE(PG8_SA(1, 1), a1 + hstep, voffA);
            PG8_WAIT_V(8); PG8_WAIT_L(0); PG8_BAR; PG8_MMA(0, 0, At, B0); PG8_MMA(0, 1, At, B1); PG8_BAR; PG8_SCHED;
            PG8_LDA(At, 0, 1); PG8_STAGE(PG8_SB(0, 0), b2, voffB); PG8_STAGE(PG8_SB(0, 1), b2 + hstep, voffB); PG8_STAGE(PG8_SA(0, 0), a2, voffA);
            PG8_WAIT_V(8); PG8_WAIT_L(0); PG8_BAR; PG8_MMA(1, 0, At, B0); PG8_MMA(1, 1, At, B1); PG8_BAR; PG8_SCHED;
            PG8_LDB(B0, 1, 0); PG8_LDB(B1, 1, 1); PG8_SCHED; PG8_LDA(At, 1, 0); PG8_STAGE(PG8_SA(0, 1), a2 + hstep, voffA);
            PG8_WAIT_V(8); PG8_WAIT_L(0); PG8_BAR; PG8_MMA(0, 0, At, B0); PG8_MMA(0, 1, At, B1); PG8_BAR; PG8_SCHED;
            PG8_LDA(At, 1, 1); PG8_STAGE(PG8_SB(1, 0), b3, voffB); PG8_STAGE(PG8_SB(1, 1), b3 + hstep, voffB); PG8_STAGE(PG8_SA(1, 0), a3, voffA);
            PG8_WAIT_V(8); PG8_WAIT_L(0); PG8_BAR; PG8_MMA(1, 0, At, B0); PG8_MMA(1, 1, At, B1); PG8_BAR; PG8_SCHED;
            } else {
            PG8_LDB(B0, 0, 0); PG8_SCHED; PG8_LDA(At, 0, 0); PG8_STAGE(PG8_SA(1, 1), a1 + hstep, voffA);
            PG8_WAIT_L(8); PG8_BAR; PG8_WAIT_L(0); PG8_MMA(0, 0, At, B0); PG8_BAR; PG8_SCHED;
            PG8_LDB(B1, 0, 1); PG8_STAGE(PG8_SB(0, 0), b2, voffB);
            PG8_BAR; PG8_WAIT_L(0); PG8_MMA(0, 1, At, B1); PG8_BAR;
            PG8_LDA(At, 0, 1); PG8_STAGE(PG8_SA(0, 0), a2, voffA);
            PG8_BAR; PG8_WAIT_L(0); PG8_MMA(1, 0, At, B0); PG8_BAR; PG8_SCHED;
            PG8_STAGE(PG8_SB(0, 1), b2 + hstep, voffB);
            PG8_WAIT_V(6); PG8_BAR; PG8_MMA(1, 1, At, B1); PG8_BAR;
            PG8_LDB(B0, 1, 0); PG8_SCHED; PG8_LDA(At, 1, 0); PG8_STAGE(PG8_SA(0, 1), a2 + hstep, voffA);
            PG8_WAIT_L(8); PG8_BAR; PG8_WAIT_L(0); PG8_MMA(0, 0, At, B0); PG8_BAR; PG8_SCHED;
            PG8_LDB(B1, 1, 1); PG8_STAGE(PG8_SB(1, 0), b3, voffB);
            PG8_BAR; PG8_WAIT_L(0); PG8_MMA(0, 1, At, B1); PG8_BAR;
            PG8_LDA(At, 1, 1); PG8_STAGE(PG8_SA(1, 0), a3, voffA);
            PG8_BAR; PG8_WAIT_L(0); PG8_MMA(1, 0, At, B0); PG8_BAR; PG8_SCHED;
            PG8_STAGE(PG8_SB(1, 1), b3 + hstep, voffB);
            PG8_WAIT_V(6); PG8_BAR; PG8_MMA(1, 1, At, B1); PG8_BAR;
            }
        }
        if constexpr (ALIGN_EPI) { if (wr == 0) PG8_BAR; }
        if constexpr (!Epi::AFTER_DRAIN) { E(acc, cur, wr, wc, fr, fq); S.done(cur); }
        if (!has_next) break;
#pragma unroll
        for (int a = 0; a < 2; ++a)
#pragma unroll
            for (int b = 0; b < 2; ++b)
#pragma unroll
                for (int m = 0; m < 4; ++m)
#pragma unroll
                    for (int n = 0; n < 2; ++n) acc[a][b][m][n] = (f32x4){0.f, 0.f, 0.f, 0.f};
        cur = nxt; cA = nA; cB = nB; ++ui;
        if constexpr (ALIGN_EPI) { if (wr == 1) PG8_BAR; }
    }
    PG8_WAIT_V(0);
    if constexpr (!ALIGN_EPI) { if (wr == 0) PG8_BAR; }
    PG8_BAR;
    if constexpr (Epi::AFTER_DRAIN) { E.fused(acc, cur, wr, wc, fr, fq, lds, wid, lane); S.done(cur); }
#undef PG8_SA
#undef PG8_SB
#undef PG8_STAGE
#undef PG8_LDA
#undef PG8_LDB
#undef PG8_MMA
#undef PG8_WAIT_V
#undef PG8_WAIT_L
#undef PG8_BAR
#undef PG8_SCHED
}
}

#define LAS __attribute__((address_space(3)))
typedef unsigned short bf16;
typedef float f32x4 __attribute__((ext_vector_type(4)));
typedef float f32x16 __attribute__((ext_vector_type(16)));
typedef short bf16x8 __attribute__((ext_vector_type(8)));
typedef unsigned u32x4 __attribute__((ext_vector_type(4)));
typedef unsigned u32x2 __attribute__((ext_vector_type(2)));
constexpr int BATCH = 4, SEQ = 8192, D = 1024, M = BATCH * SEQ, FF = 2816, NH = 8;
constexpr size_t MiB = 1u << 20;
constexpr size_t WS_WIN = 0, WS_WOUT = 4 * MiB, WS_WGU0 = 6 * MiB, WS_WGU1 = 17 * MiB, WS_WDN0 = 28 * MiB, WS_WDN1 = 34 * MiB, WS_WQKV = 40 * MiB, WS_WO = 46 * MiB, WS_WSP = 48 * MiB;
constexpr size_t WS_SS = 50 * MiB;
constexpr size_t WS_CTL = 60 * MiB;
constexpr size_t WS_BAR = 61 * MiB;
constexpr size_t WS_XB = 64 * MiB;
constexpr size_t WS_R1 = 128 * MiB, WS_R2 = 192 * MiB, WS_R3 = 256 * MiB;
constexpr size_t WS_O = 320 * MiB, WS_END = 384 * MiB;
constexpr int NWAVES = 8, NTHR = 512;
constexpr int LDS_BYTES = 147456;
constexpr float LOG2E = 1.4426950408889634f;
constexpr float LAMBDA_INIT = 0.35550906f;

__device__ __forceinline__ unsigned pk2(float lo, float hi) { return pg8::cvt_pk_bf16(lo, hi); }
__device__ __forceinline__ float bf2f(unsigned short h) { return __builtin_bit_cast(float, (unsigned)h << 16); }
__device__ __forceinline__ float bflo(unsigned w) { return __builtin_bit_cast(float, w << 16); }
__device__ __forceinline__ float bfhi(unsigned w) { return __builtin_bit_cast(float, w & 0xffff0000u); }
__device__ __forceinline__ float wave_sum(float v) {
#pragma unroll
    for (int o = 1; o < 64; o <<= 1) v += __shfl_xor(v, o);
    return v;
}

struct ConvD { const float* W; int K, N; bf16* WT; int row_off, mode; const float* gain; int gmask; float scale; int item; };
__device__ __forceinline__ void conv_load(const ConvD& d, int lane, f32x4 (&wv)[8]) {
    const int nblk = d.N / 32, kb = d.item / nblk, nb = d.item % nblk, k0 = 64 * kb, n0 = 32 * nb;
#pragma unroll
    for (int i = 0; i < 8; ++i) wv[i] = __builtin_nontemporal_load((const f32x4*)(d.W + (size_t)(k0 + 8 * i + (lane >> 3)) * d.N + n0 + 4 * (lane & 7)));
}
__device__ __forceinline__ void conv_fin(const ConvD& d, const f32x4 (&wv)[8], LAS float* scr, int lane) {
    const int nblk = d.N / 32, kb = d.item / nblk, nb = d.item % nblk, k0 = 64 * kb, n0 = 32 * nb;
#pragma unroll
    for (int i = 0; i < 8; ++i) { const int kk = 8 * i + (lane >> 3); const float g = d.gain ? d.gain[(k0 + kk) & d.gmask] * d.scale : d.scale;
        LAS float* p = scr + kk * 33 + 4 * (lane & 7); p[0] = wv[i][0] * g; p[1] = wv[i][1] * g; p[2] = wv[i][2] * g; p[3] = wv[i][3] * g; }
    asm volatile("s_waitcnt lgkmcnt(0)" ::: "memory");
    int rbase;
    if (d.mode == 0) rbase = d.row_off + n0; else { const int nn = (n0 < FF) ? n0 : n0 - FF; rbase = (nn >> 7) * 256 + (nn & 127) + ((n0 < FF) ? 0 : 128); }
    const int c = lane & 7;
#pragma unroll
    for (int j = 0; j < 4; ++j) { const int n = (lane >> 3) + 8 * j; const LAS float* s = scr + (8 * c) * 33 + n;
        u32x4 o; o.x = pk2(s[0 * 33], s[1 * 33]); o.y = pk2(s[2 * 33], s[3 * 33]); o.z = pk2(s[4 * 33], s[5 * 33]); o.w = pk2(s[6 * 33], s[7 * 33]);
        *(u32x4*)(d.WT + (size_t)(rbase + n) * d.K + k0 + 8 * c) = o; }
    asm volatile("s_waitcnt lgkmcnt(0)" ::: "memory");
}

struct Ptrs {
    const float* in[18]; float* out; unsigned char* ws; int ph_lo, ph_hi;
};

__device__ __forceinline__ void p0_prologue(const Ptrs& P, LAS unsigned char* lds, int vcu, int G, int wave, int lane, int tid) {
    LAS float* scr = (LAS float*)(lds + wave * 16384);
    const int gw = vcu * NWAVES + wave, NGW = G * NWAVES;
    unsigned char* ws = P.ws;
    constexpr int I_WIN = 16 * 64, I_WOUT = 16 * 32, I_GU = 16 * 176, I_DN = 44 * 32, I_Q = 16 * 32, I_KV = 16 * 64, I_O = 16 * 32;
    constexpr int NITEMS = I_WIN + I_WOUT + 2 * I_GU + 2 * I_DN + I_Q + I_KV + I_O;
    auto desc = [&](int it) -> ConvD {
        int r = it;
        if (r < I_WIN) return ConvD{P.in[2], D, 2 * D, (bf16*)(ws + WS_WIN), 0, 0, P.in[1], 1023, 1.f, r}; r -= I_WIN;
        if (r < I_WOUT) return ConvD{P.in[6], D, D, (bf16*)(ws + WS_WOUT), 0, 0, nullptr, 0, 1.f, r}; r -= I_WOUT;
        if (r < I_GU) return ConvD{P.in[8], D, 2 * FF, (bf16*)(ws + WS_WGU0), 0, 1, P.in[7], 1023, 1.f, r}; r -= I_GU;
        if (r < I_GU) return ConvD{P.in[8] + (size_t)D * 2 * FF, D, 2 * FF, (bf16*)(ws + WS_WGU1), 0, 1, P.in[7] + D, 1023, 1.f, r}; r -= I_GU;
        if (r < I_DN) return ConvD{P.in[9], FF, D, (bf16*)(ws + WS_WDN0), 0, 0, nullptr, 0, 1.f, r}; r -= I_DN;
        if (r < I_DN) return ConvD{P.in[9] + (size_t)FF * D, FF, D, (bf16*)(ws + WS_WDN1), 0, 0, nullptr, 0, 1.f, r}; r -= I_DN;
        if (r < I_Q) return ConvD{P.in[13], D, D, (bf16*)(ws + WS_WQKV), 0, 0, P.in[12], 1023, 0.125f * LOG2E, r}; r -= I_Q;
        if (r < I_KV) return ConvD{P.in[11], D, 2 * D, (bf16*)(ws + WS_WQKV), D, 0, P.in[10], 1023, 1.f, r}; r -= I_KV;
        return ConvD{P.in[16], D, D, (bf16*)(ws + WS_WO), 0, 0, P.in[15], 127, 1.0f - LAMBDA_INIT, r};
    };
    if (gw < NITEMS) { int it = gw; ConvD dA = desc(it), dB = dA; f32x4 wA[8], wB[8]; conv_load(dA, lane, wA);
        for (;;) { const int itB = it + NGW; const bool hb = itB < NITEMS; if (hb) { dB = desc(itB); conv_load(dB, lane, wB); }
            conv_fin(dA, wA, scr, lane); if (!hb) break;
            const int itA = itB + NGW; const bool ha = itA < NITEMS; if (ha) { dA = desc(itA); conv_load(dA, lane, wA); }
            conv_fin(dB, wB, scr, lane); if (!ha) break; it = itA; } }
    if (vcu == 0) { unsigned* ctl = (unsigned*)(ws + WS_CTL); if (tid < 128) ctl[tid] = 0u; if (tid < 8) ctl[1024 + 32 * tid] = 0u; }
    { bf16* wsp = (bf16*)(ws + WS_WSP); const float* w = P.in[4];
      for (int i = vcu * NTHR + tid; i < 8 * 128 * 128; i += G * NTHR) { const int t = (i >> 7) & 127, s = i & 127; wsp[i] = (bf16)(pk2(s <= t ? w[i] : 0.f, 0.f) & 0xffffu); } }
    { const float* x = P.in[0]; bf16* xb = (bf16*)(ws + WS_XB); float* ss0 = (float*)(ws + WS_SS);
      for (int m0 = gw * 16; m0 < M; m0 += NGW * 16) { float mine = 0.f;
          for (int k2 = 0; k2 < 16; k2 += 2) {
          f32x4 v[2][4];
#pragma unroll
          for (int u = 0; u < 2; ++u) { const f32x4* xr = (const f32x4*)(x + (size_t)(m0 + k2 + u) * D) + lane;
#pragma unroll
              for (int j = 0; j < 4; ++j) v[u][j] = __builtin_nontemporal_load(xr + 64 * j); }
#pragma unroll
          for (int u = 0; u < 2; ++u) { const int m = m0 + k2 + u; float s = 0.f;
#pragma unroll
              for (int j = 0; j < 4; ++j) s += (v[u][j][0] * v[u][j][0] + v[u][j][1] * v[u][j][1]) + (v[u][j][2] * v[u][j][2] + v[u][j][3] * v[u][j][3]);
              s = wave_sum(s);
              u32x2* o8 = (u32x2*)(xb + (size_t)m * D) + lane;
#pragma unroll
              for (int j = 0; j < 4; ++j) { u32x2 w; w.x = pk2(v[u][j][0], v[u][j][1]); w.y = pk2(v[u][j][2], v[u][j][3]); o8[64 * j] = w; }
              if (lane == k2 + u) mine = s; } }
          if (lane < 16) { ss0[m0 + lane] = mine;
#pragma unroll
              for (int j = 1; j < 4; ++j) ss0[(size_t)j * M + m0 + lane] = 0.f; }
      } }
}

constexpr int SP_PITCH = 136;
__device__ __forceinline__ void spatial_phase(LAS unsigned char* lds, const bf16* U, const bf16* VV, const bf16* WSP, const float* vgain, const float* bsp, bf16* UZ, int vcu, int G, int wave, int lane, int tid) {
    LAS bf16* vt = (LAS bf16*)lds;
    LAS float* mu_s = (LAS float*)(lds + 36864); LAS float* rs_s = mu_s + 128;
    const int l31 = lane & 31, hi = lane >> 5, dblk = wave & 3, pp = wave >> 2;
    for (int unit = vcu; unit < M / 128; unit += G) {
        const int tok0 = unit * 128;
        for (int rr = 0; rr < 16; ++rr) { const int s = wave * 16 + rr; const bf16* rp = VV + (size_t)(tok0 + s) * D;
            const u32x4 a = *(const u32x4*)(rp + lane * 8), b = *(const u32x4*)(rp + 512 + lane * 8);
            float f[16]; f[0] = bflo(a.x); f[1] = bfhi(a.x); f[2] = bflo(a.y); f[3] = bfhi(a.y); f[4] = bflo(a.z); f[5] = bfhi(a.z); f[6] = bflo(a.w); f[7] = bfhi(a.w);
            f[8] = bflo(b.x); f[9] = bfhi(b.x); f[10] = bflo(b.y); f[11] = bfhi(b.y); f[12] = bflo(b.z); f[13] = bfhi(b.z); f[14] = bflo(b.w); f[15] = bfhi(b.w);
            float sm = 0.f;
#pragma unroll
            for (int j = 0; j < 16; ++j) sm += f[j];
            const float mean = wave_sum(sm) * (1.0f / D); float q = 0.f;
#pragma unroll
            for (int j = 0; j < 16; ++j) { const float d = f[j] - mean; q += d * d; }
            const float var = wave_sum(q) * (1.0f / D);
            if (lane == 0) { mu_s[s] = mean; rs_s[s] = rsqrtf(var + 1e-6f); } }
        __syncthreads();
        for (int g = 0; g < 8; ++g) {
            const int s = tid >> 2, dp = tid & 3; const bf16* rp = VV + (size_t)(tok0 + s) * D + g * 128;
            u32x4 vp4[4];
#pragma unroll
            for (int i = 0; i < 4; ++i) vp4[i] = *(const u32x4*)(rp + i * 32 + dp * 8);
            bf16x8 wf[2][8]; u32x2 uu[2][4]; float bias[2];
#pragma unroll
            for (int sel = 0; sel < 2; ++sel) { const int tb = sel ? 3 - pp : pp; const bf16* bp = WSP + ((size_t)(g * 128 + tb * 32 + l31)) * 128 + 8 * hi;
#pragma unroll
                for (int ks = 0; ks < 8; ++ks) { if (ks < 2 * (tb + 1)) wf[sel][ks] = *(const bf16x8*)(bp + 16 * ks); else wf[sel][ks] = (bf16x8){0, 0, 0, 0, 0, 0, 0, 0}; }
                const int t = tb * 32 + l31; bias[sel] = bsp[g * 128 + t]; const size_t ro = (size_t)(tok0 + t) * D + g * 128 + dblk * 32 + 4 * hi;
#pragma unroll
                for (int q4 = 0; q4 < 4; ++q4) uu[sel][q4] = *(const u32x2*)(U + ro + 8 * q4); }
            { const float mu = mu_s[s], rs = rs_s[s];
#pragma unroll
              for (int i = 0; i < 4; ++i) { const int c = i * 32 + dp * 8; const u32x4 a = vp4[i];
                  const f32x4 g0 = *(const f32x4*)(vgain + g * 128 + c), g1 = *(const f32x4*)(vgain + g * 128 + c + 4);
                  float f[8]; f[0] = bflo(a.x); f[1] = bfhi(a.x); f[2] = bflo(a.y); f[3] = bfhi(a.y); f[4] = bflo(a.z); f[5] = bfhi(a.z); f[6] = bflo(a.w); f[7] = bfhi(a.w);
#pragma unroll
                  for (int j = 0; j < 8; ++j) { const float gg = (j < 4) ? g0[j & 3] : g1[j & 3]; const float v = (f[j] - mu) * rs * gg; vt[(c + j) * SP_PITCH + s] = (bf16)(pk2(v, 0.f) & 0xffffu); } } }
            __syncthreads();
#pragma unroll
            for (int sel = 0; sel < 2; ++sel) { const int tb = sel ? 3 - pp : pp; const int nks = 2 * (tb + 1);
                f32x16 acc = {};
                const LAS bf16* ap = vt + (dblk * 32 + l31) * SP_PITCH + 8 * hi;
#pragma unroll
                for (int ks = 0; ks < 8; ++ks) { if (ks < nks) { const bf16x8 a = *(const LAS bf16x8*)(ap + 16 * ks); acc = __builtin_amdgcn_mfma_f32_32x32x16_bf16(a, wf[sel][ks], acc, 0, 0, 0); } }
                const int t = tb * 32 + l31; const size_t ro = (size_t)(tok0 + t) * D + g * 128 + dblk * 32 + 4 * hi; const float bs = bias[sel];
#pragma unroll
                for (int q4 = 0; q4 < 4; ++q4) { const u32x2 u2 = uu[sel][q4];
                    const float z0 = acc[4 * q4 + 0] + bs, z1 = acc[4 * q4 + 1] + bs, z2 = acc[4 * q4 + 2] + bs, z3 = acc[4 * q4 + 3] + bs;
                    u32x2 w; w.x = pk2(bflo(u2.x) * z0, bfhi(u2.x) * z1); w.y = pk2(bflo(u2.y) * z2, bfhi(u2.y) * z3); *(u32x2*)(UZ + ro + 8 * q4) = w; } }
            __syncthreads();
        }
    }
}
constexpr int AT_KP = 136, AT_VP = 72, AT_KBYTES = 64 * AT_KP * 2, AT_VBYTES = 128 * AT_VP * 2;
constexpr int AT_VOFF = 2 * AT_KBYTES;
constexpr int AT_FLAG = 73728;
constexpr float AT_THR = 6.0f;
__device__ __forceinline__ int crow(int r, int hi) { return (r & 3) + 8 * (r >> 2) + 4 * hi; }
__device__ __forceinline__ float max3f(float a, float b, float c) { float r; asm("v_max3_f32 %0, %1, %2, %3" : "=v"(r) : "v"(a), "v"(b), "v"(c)); return r; }
__device__ __forceinline__ float xhalf_max(float v) { auto rr = __builtin_amdgcn_permlane32_swap(__float_as_uint(v), __float_as_uint(v), false, false); return fmaxf(__uint_as_float(rr[0]), __uint_as_float(rr[1])); }
__device__ __forceinline__ float xhalf_sum(float v) { auto rr = __builtin_amdgcn_permlane32_swap(__float_as_uint(v), __float_as_uint(v), false, false); return __uint_as_float(rr[0]) + __uint_as_float(rr[1]); }
constexpr float AT_STOP = 32.0f;
__device__ __forceinline__ void attn_unit(LAS unsigned char* lds, const bf16* Q, const bf16* K, const bf16* VT, bf16* O, const float* KN, int b, int h, int qb, float lam, int wave, int lane, int tid) {
    const int rg = wave & 3, mp = wave >> 2, l31 = lane & 31, hi = lane >> 5;
    const int q0 = qb * 128, NT = 2 * (qb + 1);
    const size_t rowbase = (size_t)b * SEQ;
    const float slope2 = exp2f(-(float)(h + 1)) * LOG2E;
    const int qrel = 32 * rg + l31;
    bf16x8 qf[4];
    float ub;
    { const bf16* qp = Q + (rowbase + q0 + qrel) * D + h * 128 + mp * 64 + 8 * hi; float qs = 0.f;
#pragma unroll
      for (int ks = 0; ks < 4; ++ks) { qf[ks] = *(const bf16x8*)(qp + 16 * ks);
#pragma unroll
          for (int e = 0; e < 8; ++e) { const float v = bf2f((unsigned short)qf[ks][e]); qs += v * v; } }
      qs = xhalf_sum(qs);
      const float* kn = KN + ((b * 8 + h) * 2 + mp) * 2; const float k2 = kn[0] + kn[1];
      ub = sqrtf(qs * k2) * 1.002f + 1e-3f; }
    f32x16 o[4];
#pragma unroll
    for (int i = 0; i < 4; ++i) o[i] = (f32x16){};
    float mref = 0.f, lrun = 0.f; bool inited = false;
    const bool lean = (__all(2.f * ub + AT_THR < 100.f) != 0);
    const float abl = slope2 * (float)(4 * hi - qrel);
    const bf16* kg0 = K + (rowbase + q0 + 64 + (tid >> 4)) * D + h * 128 + (tid & 15) * 8;
    const bf16* vg0 = VT + ((size_t)((b * 8 + h) * 128 + (tid >> 3))) * SEQ + q0 + 64 + (tid & 7) * 8;
    const int kl0 = ((tid >> 4) * AT_KP + (tid & 15) * 8) * 2, vl0 = ((tid >> 3) * AT_VP + (tid & 7) * 8) * 2;
    LAS unsigned* flags = (LAS unsigned*)(lds + AT_FLAG);
    u32x4 kr0, kr1, vr0, vr1;
#define AT_LDK(j) do { const bf16* p_ = kg0 - (size_t)(j) * 64 * D; kr0 = *(const u32x4*)p_; kr1 = *(const u32x4*)(p_ + 32 * D); } while (0)
#define AT_LDV(j) do { const bf16* p_ = vg0 - (size_t)(j) * 64; vr0 = *(const u32x4*)p_; vr1 = *(const u32x4*)(p_ + (size_t)64 * SEQ); } while (0)
#define AT_STK(slot) do { *(LAS u32x4*)(lds + (slot) * AT_KBYTES + kl0) = kr0; *(LAS u32x4*)(lds + (slot) * AT_KBYTES + kl0 + 32 * AT_KP * 2) = kr1; } while (0)
#define AT_STV(slot) do { *(LAS u32x4*)(lds + AT_VOFF + (slot) * AT_VBYTES + vl0) = vr0; *(LAS u32x4*)(lds + AT_VOFF + (slot) * AT_VBYTES + vl0 + 64 * AT_VP * 2) = vr1; } while (0)
#define AT_QK(S0, S1, j) do { const float c_ = (slope2 * (float)(64 - 64 * (j)) - mref) + abl; const float c1_ = c_ + 32.f * slope2; \
        const LAS bf16* kb_ = (const LAS bf16*)(lds + ((j) & 1) * AT_KBYTES) + l31 * AT_KP + mp * 64 + 8 * hi; \
        bf16x8 ka_[4], kc_[4]; \
        _Pragma("unroll") for (int ks = 0; ks < 4; ++ks) { ka_[ks] = *(const LAS bf16x8*)(kb_ + 16 * ks); kc_[ks] = *(const LAS bf16x8*)(kb_ + 32 * AT_KP + 16 * ks); } \
        _Pragma("unroll") for (int r = 0; r < 16; ++r) { const float sk_ = slope2 * (float)crow(r, 0); S0[r] = c_ + sk_; S1[r] = c1_ + sk_; } \
        __builtin_amdgcn_sched_barrier(0); __builtin_amdgcn_s_setprio(1); \
        _Pragma("unroll") for (int ks = 0; ks < 4; ++ks) { \
            S0 = __builtin_amdgcn_mfma_f32_32x32x16_bf16(ka_[ks], qf[ks], S0, 0, 0, 0); S1 = __builtin_amdgcn_mfma_f32_32x32x16_bf16(kc_[ks], qf[ks], S1, 0, 0, 0); } __builtin_amdgcn_s_setprio(0); } while (0)
#define AT_VRD(dst, kk) do { _Pragma("unroll") for (int i = 0; i < 4; ++i) dst[i] = *(const LAS bf16x8*)(vb + i * 32 * AT_VP + 16 * (kk)); } while (0)
#define AT_PVM(src, kk) do { __builtin_amdgcn_s_setprio(1); _Pragma("unroll") for (int i = 0; i < 4; ++i) o[i] = __builtin_amdgcn_mfma_f32_32x32x16_bf16(src[i], __builtin_bit_cast(bf16x8, pk[kk]), o[i], 0, 0, 0); __builtin_amdgcn_s_setprio(0); } while (0)
    AT_LDK(0); AT_LDV(0); AT_STK(0); AT_STV(0);
    __syncthreads();
    for (int j = 0; j < NT; ++j) {
        const bool hasn = (j + 1 < NT);
        if (hasn) { AT_LDK(j + 1); AT_LDV(j + 1); }
        u32x4 fa = (u32x4){0u, 0u, 0u, 0u}, fb = fa;
        if (j > 0) { const LAS u32x4* fp = (const LAS u32x4*)(flags + ((j - 1) & 1) * 8); fa = fp[0]; fb = fp[1]; }
        f32x16 c0, c1;
        AT_QK(c0, c1, j);
        if ((fa.x & fa.y & fa.z & fa.w & fb.x & fb.y & fb.z & fb.w) != 0u) break;
        const LAS bf16* vb = (const LAS bf16*)(lds + AT_VOFF + (j & 1) * AT_VBYTES) + l31 * AT_VP + 8 * hi;
        bf16x8 vA[4], vB[4];
        AT_VRD(vA, 0);
        if (j < 2 || !lean) {
        if (j < 2) { const int kvb = 64 - 64 * j;
#pragma unroll
            for (int r = 0; r < 16; ++r) { const int kv = kvb + crow(r, hi); if (kv > qrel) c0[r] = -INFINITY; if (kv + 32 > qrel) c1[r] = -INFINITY; } }
        float mx = max3f(c0[0], c1[0], c0[1]), mx2 = max3f(c1[1], c0[2], c1[2]);
#pragma unroll
        for (int r = 3; r < 15; r += 2) { mx = max3f(mx, c0[r], c1[r]); mx2 = max3f(mx2, c0[r + 1], c1[r + 1]); }
        mx = xhalf_max(max3f(mx, mx2, fmaxf(c0[15], c1[15])));
        const bool need = (mx > AT_THR) || (!inited && mx > -1e30f);
        if (__any(need)) { const float dl = need ? mx : 0.f; const float f = (need && inited) ? __builtin_amdgcn_exp2f(-dl) : 1.f;
            mref += dl; lrun *= f; inited = inited || need;
#pragma unroll
            for (int r = 0; r < 16; ++r) { c0[r] -= dl; c1[r] -= dl; }
#pragma unroll
            for (int i = 0; i < 4; ++i) {
#pragma unroll
                for (int r = 0; r < 16; ++r) o[i][r] *= f; } }
        }
        { const bool can = inited && (ub - slope2 * (float)(qrel + 64 * j - 63) - mref < -AT_STOP);
          const bool wv = (__all(can) != 0) && (j >= 1);
          if (lane == 0) flags[(j & 1) * 8 + wave] = wv ? 1u : 0u; }
        float ls = 0.f;
#pragma unroll
        for (int r = 0; r < 16; ++r) { c0[r] = __builtin_amdgcn_exp2f(c0[r]); c1[r] = __builtin_amdgcn_exp2f(c1[r]); ls += c0[r] + c1[r]; }
        lrun += ls;
        u32x4 pk[4];
#pragma unroll
        for (int s = 0; s < 2; ++s) {
            pk[s]     = (u32x4){pk2(c0[8 * s + 0], c0[8 * s + 1]), pk2(c0[8 * s + 2], c0[8 * s + 3]), pk2(c0[8 * s + 4], c0[8 * s + 5]), pk2(c0[8 * s + 6], c0[8 * s + 7])};
            pk[2 + s] = (u32x4){pk2(c1[8 * s + 0], c1[8 * s + 1]), pk2(c1[8 * s + 2], c1[8 * s + 3]), pk2(c1[8 * s + 4], c1[8 * s + 5]), pk2(c1[8 * s + 6], c1[8 * s + 7])}; }
        __builtin_amdgcn_sched_barrier(0);
        AT_VRD(vB, 1); __builtin_amdgcn_sched_barrier(0); AT_PVM(vA, 0); __builtin_amdgcn_sched_barrier(0);
        AT_VRD(vA, 2); __builtin_amdgcn_sched_barrier(0); AT_PVM(vB, 1); __builtin_amdgcn_sched_barrier(0);
        AT_VRD(vB, 3); __builtin_amdgcn_sched_barrier(0); AT_PVM(vA, 2); __builtin_amdgcn_sched_barrier(0);
        AT_PVM(vB, 3);
        if (hasn) { AT_STK((j + 1) & 1); AT_STV((j + 1) & 1); }
        __syncthreads();
    }
#undef AT_LDK
#undef AT_LDV
#undef AT_STK
#undef AT_STV
#undef AT_QK
#undef AT_VRD
#undef AT_PVM
    lrun = xhalf_sum(lrun);
    const float inv = 1.0f / lrun;
    LAS float* ex = (LAS float*)lds + (size_t)rg * 64 * 64;
    if (mp == 1) { const float sc = lam * inv;
#pragma unroll
        for (int i = 0; i < 4; ++i)
#pragma unroll
            for (int r = 0; r < 16; ++r) ex[(i * 16 + r) * 64 + lane] = o[i][r] * sc; }
    __syncthreads();
    if (mp == 0) { float ssq = 0.f;
#pragma unroll
        for (int i = 0; i < 4; ++i)
#pragma unroll
            for (int r = 0; r < 16; ++r) { const float v = o[i][r] * inv - ex[(i * 16 + r) * 64 + lane]; o[i][r] = v; ssq += v * v; }
        ssq = xhalf_sum(ssq);
        const float rn = rsqrtf(ssq * (1.0f / 128.0f) + 1e-6f);
        bf16* op = O + (rowbase + q0 + qrel) * D + h * 128 + 4 * hi;
#pragma unroll
        for (int i = 0; i < 4; ++i)
#pragma unroll
            for (int q4 = 0; q4 < 4; ++q4) { u32x2 w; w.x = pk2(o[i][4 * q4] * rn, o[i][4 * q4 + 1] * rn); w.y = pk2(o[i][4 * q4 + 2] * rn, o[i][4 * q4 + 3] * rn);
                *(u32x2*)(op + i * 32 + 8 * q4) = w; } }
    __syncthreads();
}
__device__ __forceinline__ int attn_fetch(unsigned* ctr, int myq) {
    for (int t = 0; t < 8; ++t) { const int q = (myq + t) & 7; const unsigned idx = __hip_atomic_fetch_add(ctr + 32 * q, 1u, __ATOMIC_RELAXED, __HIP_MEMORY_SCOPE_AGENT); if (idx < 256u) return q * 256 + (int)idx; }
    return -1;
}
__device__ __forceinline__ void attn_phase(LAS unsigned char* lds, const bf16* Q, const bf16* K, const bf16* VT, bf16* O, const float* lamv, const float* KN, unsigned* ctr, int wave, int lane, int tid) {
    const float a = wave_sum(lamv[lane] * lamv[64 + lane]), c = wave_sum(lamv[128 + lane] * lamv[192 + lane]);
    const float lam = expf(a) - expf(c) + LAMBDA_INIT;
    LAS int* itemw = (LAS int*)(lds + AT_FLAG + 64);
    const int myq = blockIdx.x & 7;
    if (tid == 0) *itemw = attn_fetch(ctr, myq);
    __syncthreads();
    for (;;) {
        const int item = *itemw;
        if (item < 0) break;
        const int q = item >> 8, idx = item & 255, hs = idx >> 6, qb = 63 - (idx & 63);
        const int h = (q & 1) ? ((hs == 0) ? 6 : (hs == 1) ? 5 : (hs == 2) ? 2 : 1) : ((hs == 0) ? 7 : (hs == 1) ? 4 : (hs == 2) ? 3 : 0);
        unsigned pre = 0u;
        if (tid == 0) pre = __hip_atomic_fetch_add(ctr + 32 * myq, 1u, __ATOMIC_RELAXED, __HIP_MEMORY_SCOPE_AGENT);
        attn_unit(lds, Q, K, VT, O, KN, q >> 1, h, qb, lam, wave, lane, tid);
        if (tid == 0) *itemw = (pre < 256u) ? (myq * 256 + (int)pre) : attn_fetch(ctr, myq + 1);
        __syncthreads();
    }
}

__device__ __forceinline__ void final_phase(const bf16* xb, float* out, const float* ss, const float* gain, int vcu, int G, int wave, int lane) {
    const int gw = vcu * NWAVES + wave, NGW = G * NWAVES;
    f32x4 g[4];
#pragma unroll
    for (int j = 0; j < 2; ++j) { g[2 * j] = *(const f32x4*)(gain + 512 * j + 8 * lane); g[2 * j + 1] = *(const f32x4*)(gain + 512 * j + 8 * lane + 4); }
    for (int m = gw; m < M; m += NGW) {
        float sl = ss[(size_t)(lane & 3) * 32768 + m]; sl += __shfl_xor(sl, 1); sl += __shfl_xor(sl, 2);
        const u32x4 w0 = *(const u32x4*)(xb + (size_t)m * D + 8 * lane), w1 = *(const u32x4*)(xb + (size_t)m * D + 512 + 8 * lane);
        const float r = rsqrtf(sl * (1.0f / D) + 1e-6f);
        float* orow = out + (size_t)m * D + 8 * lane;
        __builtin_nontemporal_store((f32x4)((f32x4){bflo(w0.x), bfhi(w0.x), bflo(w0.y), bfhi(w0.y)} * r * g[0]), (f32x4*)(orow));
        __builtin_nontemporal_store((f32x4)((f32x4){bflo(w0.z), bfhi(w0.z), bflo(w0.w), bfhi(w0.w)} * r * g[1]), (f32x4*)(orow + 4));
        __builtin_nontemporal_store((f32x4)((f32x4){bflo(w1.x), bfhi(w1.x), bflo(w1.y), bfhi(w1.y)} * r * g[2]), (f32x4*)(orow + 512));
        __builtin_nontemporal_store((f32x4)((f32x4){bflo(w1.z), bfhi(w1.z), bflo(w1.w), bfhi(w1.w)} * r * g[3]), (f32x4*)(orow + 516));
    }
}

#define XB_TMO      128
#define XB_XCNT(j)  (256  + 64 * (j))
#define XB_XSUB(j)  (1280 + 64 * (j))
#define XB_XGEN(j)  (2304 + 64 * (j))
#define XB_TOP      3328
#define XB_TOPGEN   3392
#define XCD_BAR_WORDS 3456
#define XB_SPIN_CAP (1u << 18)

__device__ __forceinline__ unsigned xb_ld(unsigned* p)              { return __hip_atomic_load(p, __ATOMIC_RELAXED, __HIP_MEMORY_SCOPE_AGENT); }
__device__ __forceinline__ unsigned xb_add(unsigned* p, unsigned v) { return __hip_atomic_fetch_add(p, v, __ATOMIC_RELAXED, __HIP_MEMORY_SCOPE_AGENT); }
__device__ __forceinline__ unsigned xb_xcc_id() { return (unsigned)__builtin_amdgcn_s_getreg((3 << 11) | 20) & 0xFu; }
#define XB_SPIN(cond, bar) do { unsigned _sp = 0; while (cond) { __builtin_amdgcn_s_sleep(1); \
    if ((++_sp & 255u) == 0u) { if (xb_ld(&(bar)[XB_TMO])) break; if (_sp > XB_SPIN_CAP) { atomicAdd(&(bar)[XB_TMO], 1u); break; } } } } while (0)

struct XcdBarrier {
    unsigned* bar; unsigned x;
    volatile LAS unsigned* st;
};

__device__ __forceinline__ XcdBarrier xcd_barrier_post(unsigned* bar, volatile LAS unsigned* st) {
    XcdBarrier b; b.bar = bar; b.x = xb_xcc_id(); b.st = st;
    if (threadIdx.x == 0) (void)xb_add(&bar[XB_XCNT(b.x)], 1u);
    return b;
}
__device__ __forceinline__ void xcd_barrier_complete(unsigned* bar, unsigned x, unsigned& nloc, unsigned& nx) {
    const unsigned G = gridDim.x * gridDim.y * gridDim.z;
    unsigned sum, cnt, mine, sp = 0u;
    for (;;) {
        sum = 0u; cnt = 0u; mine = 0u;
#pragma unroll
        for (unsigned j = 0; j < 16; ++j) { const unsigned c = xb_ld(&bar[XB_XCNT(j)]); sum += c; cnt += (c > 0u) ? 1u : 0u; mine = (j == x) ? c : mine; }
        if (sum == G) break;
        __builtin_amdgcn_s_sleep(1);
        if ((++sp & 255u) == 0u) { if (xb_ld(&bar[XB_TMO])) break; if (sp > XB_SPIN_CAP) { atomicAdd(&bar[XB_TMO], 1u); break; } }
    }
    nloc = mine > 0u ? mine : 1u; nx = cnt > 0u ? cnt : 1u;
}

__device__ __forceinline__ void xcd_barrier(const XcdBarrier& b) {
    asm volatile("s_waitcnt vmcnt(0)" ::: "memory");
    __syncthreads();
    if (threadIdx.x == 0) {
        unsigned* bar = b.bar;
        __builtin_amdgcn_s_waitcnt(0);
        unsigned nloc = b.st[0], nx = b.st[1];
        if (nloc == 0u) { xcd_barrier_complete(bar, b.x, nloc, nx); b.st[0] = nloc; b.st[1] = nx; }
        const unsigned old = xb_add(&bar[XB_XSUB(b.x)], 1u);
        const unsigned gen = old / nloc;
        if (old + 1u == (gen + 1u) * nloc) {
            __builtin_amdgcn_fence(__ATOMIC_RELEASE, "agent");
            asm volatile("s_waitcnt vmcnt(0)" ::: "memory");
            const unsigned og = xb_add(&bar[XB_TOP], 1u);
            const unsigned tg = og / nx;
            if (og + 1u == (tg + 1u) * nx) xb_add(&bar[XB_TOPGEN], 1u);
            else XB_SPIN(xb_ld(&bar[XB_TOPGEN]) == tg, bar);
            __builtin_amdgcn_fence(__ATOMIC_ACQUIRE, "agent");
            xb_add(&bar[XB_XGEN(b.x)], 1u);
            asm volatile("s_waitcnt vmcnt(0)" ::: "memory");
        } else {
            XB_SPIN(xb_ld(&bar[XB_XGEN(b.x)]) == gen, bar);
            __builtin_amdgcn_fence(__ATOMIC_ACQUIRE, "agent");
            asm volatile("s_waitcnt vmcnt(0)" ::: "memory");
        }
    }
    __syncthreads();
}

#ifndef MK_LAUNCHES
#define MK_LAUNCHES 1
#endif
constexpr int N_PHASES = 12;
__global__ void __launch_bounds__(NTHR) yoco_fwd(Ptrs P) {
    extern __shared__ __attribute__((aligned(16))) unsigned char lds_raw[];
    LAS unsigned char* lds = (LAS unsigned char*)lds_raw;
    const int tid = threadIdx.x, lane = tid & 63, wave = __builtin_amdgcn_readfirstlane(tid >> 6);
    const int G = gridDim.x, bx = blockIdx.x; const int vcu = (G % 8 == 0) ? (bx % 8) * (G / 8) + bx / 8 : bx;
    unsigned char* ws = P.ws;
    bf16* XB = (bf16*)(ws + WS_XB); bf16* R1 = (bf16*)(ws + WS_R1); bf16* R2 = (bf16*)(ws + WS_R2); bf16* R3 = (bf16*)(ws + WS_R3); bf16* OB = (bf16*)(ws + WS_O);
    float* SS0 = (float*)(ws + WS_SS); float* SS1 = SS0 + (size_t)M * 16; float* SS2 = SS1 + (size_t)M * 16; float* SS3 = SS2 + (size_t)M * 16; float* SS4 = SS3 + (size_t)M * 16;
    const int lo = P.ph_lo, hi = P.ph_hi;
    volatile LAS unsigned* xst = (volatile LAS unsigned*)(lds + LDS_BYTES - 64);
    if (tid == 0) { xst[0] = 0u; xst[1] = 0u; }
    __syncthreads();
    XcdBarrier xbar = xcd_barrier_post((unsigned*)(ws + WS_BAR), xst);
    if (P.ph_lo > 1000) cg::this_grid().sync();
#define IN(k) (lo <= (k) && (k) < hi)
#if MK_LAUNCHES == 1
#define SEAM(k) do { if (IN(k) && IN((k) + 1)) { xcd_barrier(xbar); } } while (0)
#else
#define SEAM(k) do { } while (0)
#endif
    if (IN(0)) { p0_prologue(P, lds, vcu, G, wave, lane, tid); } SEAM(0);
    if (IN(1)) {
        pg8::Gemm g{XB, (const bf16*)(ws + WS_WIN), M, 2 * D, D}; pg8::StaticOrder S; S.init(M, 2 * D, G, bx);
        pg8::EpiGeluSplit E{R1, R2, SS0, 1, nullptr};
        pg8::gemm_phase<pg8::EpiGeluSplit, pg8::StaticOrder, true, true>(lds, g, S, E); } SEAM(1);
    if (IN(2)) { spatial_phase(lds, R1, R2, (const bf16*)(ws + WS_WSP), P.in[3], P.in[5], R3, vcu, G, wave, lane, tid); } SEAM(2);
    if (IN(3)) {
        pg8::Gemm g{R3, (const bf16*)(ws + WS_WOUT), M, D, D}; pg8::StaticOrder S; S.init(M, D, G, bx);
        pg8::EpiRes<false> E{XB, nullptr, SS1, (LAS float*)(lds + pg8::STAGE_BYTES)};
        pg8::gemm_phase<pg8::EpiRes<false>, pg8::StaticOrder, true, true>(lds, g, S, E); } SEAM(3);
    if (IN(4)) {
        pg8::Gemm g{XB, (const bf16*)(ws + WS_WGU0), M, 2 * FF, D}; pg8::StaticOrder S; S.init(M, 2 * FF, G, bx);
        pg8::EpiSwiglu E{R1, FF, SS1};
        pg8::gemm_phase<pg8::EpiSwiglu, pg8::StaticOrder, true, true>(lds, g, S, E); } SEAM(4);
    if (IN(5)) {
        pg8::Gemm g{R1, (const bf16*)(ws + WS_WDN0), M, D, FF}; pg8::StaticOrder S; S.init(M, D, G, bx);
        pg8::EpiRes<false> E{XB, nullptr, SS2, (LAS float*)(lds + pg8::STAGE_BYTES)};
        pg8::gemm_phase<pg8::EpiRes<false>, pg8::StaticOrder, true, true>(lds, g, S, E); } SEAM(5);
    if (IN(6)) {
        { pg8::Gemm g{XB, (const bf16*)(ws + WS_WQKV), M, 2 * D, D}; pg8::StaticOrder S; S.init(M, 2 * D, G, bx);
          pg8::EpiGeluSplit E{R1, R2, SS2, 0, (unsigned*)(ws + WS_CTL)};
          pg8::gemm_phase<pg8::EpiGeluSplit, pg8::StaticOrder, true, true>(lds, g, S, E); }
        { pg8::Gemm g{XB, (const bf16*)(ws + WS_WQKV) + (size_t)2 * D * D, M, D, D}; pg8::StaticOrder S; S.init(M, D, G, bx);
          pg8::EpiVT E{R3, SS2};
          pg8::gemm_phase<pg8::EpiVT, pg8::StaticOrder, true, true>(lds, g, S, E); } } SEAM(6);
    if (IN(7)) { attn_phase(lds, R1, R2, R3, OB, P.in[14], (const float*)(ws + WS_CTL), (unsigned*)(ws + WS_CTL + 4096), wave, lane, tid); } SEAM(7);
    if (IN(8)) {
        pg8::Gemm g{OB, (const bf16*)(ws + WS_WO), M, D, D}; pg8::StaticOrder S; S.init(M, D, G, bx);
        pg8::EpiRes<false> E{XB, nullptr, SS3, (LAS float*)(lds + pg8::STAGE_BYTES)};
        pg8::gemm_phase<pg8::EpiRes<false>, pg8::StaticOrder, true, true>(lds, g, S, E); } SEAM(8);
    if (IN(9)) {
        pg8::Gemm g{XB, (const bf16*)(ws + WS_WGU1), M, 2 * FF, D}; pg8::StaticOrder S; S.init(M, 2 * FF, G, bx);
        pg8::EpiSwiglu E{R1, FF, SS3};
        pg8::gemm_phase<pg8::EpiSwiglu, pg8::StaticOrder, true, true>(lds, g, S, E); } SEAM(9);
    if (IN(10)) {
        pg8::Gemm g{R1, (const bf16*)(ws + WS_WDN1), M, D, FF}; pg8::StaticOrder S; S.init(M, D, G, bx);
        pg8::EpiRes<false> E{XB, nullptr, SS4, (LAS float*)(lds + pg8::STAGE_BYTES)};
        pg8::gemm_phase<pg8::EpiRes<false>, pg8::StaticOrder, true, true>(lds, g, S, E); } SEAM(10);
    if (IN(11)) { final_phase(XB, P.out, SS4, P.in[17], vcu, G, wave, lane); }
#undef IN
#undef SEAM
}

extern "C" void kernel_launch(void* const* d_in, const int* in_sizes, int n_in, void* d_out, int out_size, void* d_ws, size_t ws_size, hipStream_t stream) {
    static int grid = 0;
    if (grid == 0) {
        if (n_in != 18 || in_sizes[0] != M * D || out_size != M * D || ws_size < WS_END) { fprintf(stderr, "kernel_launch: unexpected shapes (n_in %d, in0 %d, out %d, ws %zu)\n", n_in, n_in > 0 ? in_sizes[0] : -1, out_size, ws_size); grid = -1; return; }
        int dev = 0, cus = 0, per_cu = 0;
        (void)hipGetDevice(&dev); (void)hipDeviceGetAttribute(&cus, hipDeviceAttributeMultiprocessorCount, dev);
        if (hipFuncSetAttribute((const void*)yoco_fwd, hipFuncAttributeMaxDynamicSharedMemorySize, LDS_BYTES) != hipSuccess) { fprintf(stderr, "kernel_launch: hipFuncSetAttribute failed\n"); grid = -1; return; }
        if (hipOccupancyMaxActiveBlocksPerMultiprocessor(&per_cu, (const void*)yoco_fwd, NTHR, LDS_BYTES) != hipSuccess || per_cu < 1) { fprintf(stderr, "kernel_launch: occupancy query says %d\n", per_cu); per_cu = 1; }
        (void)hipGetLastError();
        grid = cus * 1;
        fprintf(stderr, "kernel_launch: grid %d (cus %d, per_cu %d)\n", grid, cus, per_cu);
    }
    if (grid < 0) return;
    Ptrs p{};
    for (int i = 0; i < 18; ++i) p.in[i] = (const float*)d_in[i];
    p.out = (float*)d_out; p.ws = (unsigned char*)d_ws;
#if MK_LAUNCHES == 1
    if (hipMemsetAsync((char*)d_ws + WS_BAR, 0, 3456 * sizeof(unsigned), stream) != hipSuccess) { fprintf(stderr, "kernel_launch: hipMemsetAsync of the barrier words failed\n"); return; }
    p.ph_lo = 0; p.ph_hi = N_PHASES;
    void* args[] = {&p};
    hipError_t e = hipLaunchCooperativeKernel((const void*)yoco_fwd, dim3(grid), dim3(NTHR), args, LDS_BYTES, stream);
    if (e != hipSuccess) fprintf(stderr, "kernel_launch: cooperative launch failed: %s (grid %d)\n", hipGetErrorString(e), grid);
#else
    for (int k = 0; k < N_PHASES; ++k) { p.ph_lo = k; p.ph_hi = k + 1; hipLaunchKernelGGL(yoco_fwd, dim3(grid), dim3(NTHR), LDS_BYTES, stream, p); }
#endif
}
```

```cpp
#include <hip/hip_runtime.h>
#include <hip/hip_cooperative_groups.h>
#include <cstdio>
#include <cstdint>
namespace cg = cooperative_groups;
namespace pg8 {
#define PG8_LAS __attribute__((address_space(3)))
typedef unsigned short bf16_t;
typedef short bf16x8 __attribute__((ext_vector_type(8)));
typedef float f32x4 __attribute__((ext_vector_type(4)));
typedef unsigned u32x4 __attribute__((ext_vector_type(4)));
constexpr int BM = 256, BK = 64, HALF = 128, HTB = HALF * BK * 2  , STAGE_BYTES = 8 * HTB, NXCD = 8, WGM = 8;

__host__ __device__ __forceinline__ int lds_byte(int r, int c) { const int st = (r >> 4) * 2 + (c >> 5), rr = r & 15, cc = c & 31, ob = rr * 64 + cc * 2; return st * 1024 + (ob ^ (((ob >> 9) & 1) << 5)); }
__host__ __device__ __forceinline__ void stage_rc(int b, int& R, int& C) { const int st = b / 1024, sb = b % 1024, swz = sb ^ (((sb >> 9) & 1) << 5); R = (st >> 1) * 16 + swz / 64; C = (st & 1) * 32 + (swz % 64) / 2; }
__host__ __device__ __forceinline__ int perm32(int rho) { const int n = rho >> 4, i = rho & 15; return 8 * (i >> 2) + 4 * n + (i & 3); }

struct Unit { int pm, pn; };
struct Gemm { const bf16_t* A; const bf16_t* Bt; int M, N, K; };

struct StaticOrder {
    int nM, nN, nwg, G, c;
    __host__ __device__ void init(int M, int N, int G_, int c_) { nM = M / BM; nN = N / BM; nwg = nM * nN; G = G_; c = c_; }
    __host__ __device__ bool next(int i, Unit& u) const {
        const long L = (long)i * G + c; if (L >= nwg) return false;
        int wgid = (int)L; { const int q = nwg / NXCD, r = nwg % NXCD, xcd = wgid % NXCD, off = wgid / NXCD; wgid = (xcd < r ? xcd * (q + 1) : r * (q + 1) + (xcd - r) * q) + off; }
        const int nig = WGM * nN, gid = wgid / nig, fm = gid * WGM, gsz = (nM - fm) < WGM ? (nM - fm) : WGM;
        u.pm = fm + ((wgid % nig) % gsz); u.pn = (wgid % nig) / gsz; return true;
    }
    __device__ __forceinline__ void a_ready(const Unit&) const {}
    __device__ __forceinline__ void done(const Unit&) const {}
};

typedef float f32x2 __attribute__((ext_vector_type(2)));
typedef unsigned u32x2 __attribute__((ext_vector_type(2)));
__device__ __forceinline__ unsigned cvt_pk_bf16(float lo, float hi) { typedef __bf16 b2 __attribute__((ext_vector_type(2))); f32x2 v = {lo, hi}; b2 b = __builtin_convertvector(v, b2); return __builtin_bit_cast(unsigned, b); }
constexpr int DM = 1024;
constexpr size_t SSM = 32768;
constexpr float NORM_EPS = 1e-6f;
__device__ __forceinline__ void load_rstd(const float* ss, const Unit& u, int wr, int fr, int fq, float (&rs)[2][4]) {
#pragma unroll
    for (int ai = 0; ai < 2; ++ai)
#pragma unroll
        for (int m = 0; m < 4; ++m) { const int row = u.pm * BM + ai * HALF + wr * 64 + m * 16 + fr;
            float s = ss[(size_t)fq * SSM + row];
            s += __shfl_xor(s, 16); s += __shfl_xor(s, 32); rs[ai][m] = rsqrtf(s * (1.0f / DM) + NORM_EPS); }
}
__device__ __forceinline__ float gelu_tanh(float x) { const float t = x * (1.0f + 0.044715f * x * x); const float e = __builtin_amdgcn_exp2f(-2.302208198f * t); return x * __builtin_amdgcn_rcpf(1.0f + e); }
__device__ __forceinline__ float silu_f(float x) { const float e = __builtin_amdgcn_exp2f(-1.4426950408889634f * x); return x * __builtin_amdgcn_rcpf(1.0f + e); }

struct EpiGeluSplit {
    static constexpr bool PERM = true, AFTER_DRAIN = false, SWAP = false;
    bf16_t* O0; bf16_t* O1; const float* ss; int act;
    unsigned* kn;
    __device__ __forceinline__ void operator()(const f32x4 (&acc)[2][2][4][2], const Unit& u, int wr, int wc, int fr, int fq) const {
        float rs[2][4]; load_rstd(ss, u, wr, fr, fq, rs);
        bf16_t* base = (u.pn < 4) ? O0 : O1; const int col0 = (u.pn & 3) * BM + wc * 32 + 8 * fq;
        const bool dokn = (kn != nullptr) && (u.pn >= 4); float knm[2] = {0.f, 0.f};
#pragma unroll
        for (int ai = 0; ai < 2; ++ai)
#pragma unroll
            for (int m = 0; m < 4; ++m) { const int row = u.pm * BM + ai * HALF + wr * 64 + m * 16 + fr; const float r = rs[ai][m]; bf16_t* rowp = base + (size_t)row * DM + col0;
#pragma unroll
                for (int bj = 0; bj < 2; ++bj) { f32x4 v0 = acc[ai][bj][m][0] * r, v1 = acc[ai][bj][m][1] * r;
                    if (act) {
#pragma unroll
                        for (int e = 0; e < 4; ++e) { v0[e] = gelu_tanh(v0[e]); v1[e] = gelu_tanh(v1[e]); } }
                    u32x4 w; w.x = cvt_pk_bf16(v0[0], v0[1]); w.y = cvt_pk_bf16(v0[2], v0[3]); w.z = cvt_pk_bf16(v1[0], v1[1]); w.w = cvt_pk_bf16(v1[2], v1[3]);
                    *(u32x4*)(rowp + bj * HALF) = w;
                    if (dokn) { float q = 0.f;
#pragma unroll
                        for (int e = 0; e < 4; ++e) { const float lo = __builtin_bit_cast(float, w[e] << 16), hi = __builtin_bit_cast(float, w[e] & 0xffff0000u); q += lo * lo + hi * hi; }
                        q += __shfl_xor(q, 16); q += __shfl_xor(q, 32); knm[bj] = fmaxf(knm[bj], q); } } }
        if (dokn) {
#pragma unroll
            for (int bj = 0; bj < 2; ++bj) { float q = knm[bj]; q = fmaxf(q, __shfl_xor(q, 1)); q = fmaxf(q, __shfl_xor(q, 2)); q = fmaxf(q, __shfl_xor(q, 4)); q = fmaxf(q, __shfl_xor(q, 8));
                if (fr == 0 && fq == 0) { const int b = u.pm >> 5, h = 2 * (u.pn & 3) + bj;
                    __hip_atomic_fetch_max(kn + ((b * 8 + h) * 2 + (wc >> 1)) * 2 + (wc & 1), __builtin_bit_cast(unsigned, q), __ATOMIC_RELAXED, __HIP_MEMORY_SCOPE_AGENT); } } }
    }
};
struct EpiSwiglu {
    static constexpr bool PERM = true, AFTER_DRAIN = false, SWAP = false;
    bf16_t* O; int ldo; const float* ss;
    __device__ __forceinline__ void operator()(const f32x4 (&acc)[2][2][4][2], const Unit& u, int wr, int wc, int fr, int fq) const {
        float rs[2][4]; load_rstd(ss, u, wr, fr, fq, rs);
        const int col0 = u.pn * HALF + wc * 32 + 8 * fq;
#pragma unroll
        for (int ai = 0; ai < 2; ++ai)
#pragma unroll
            for (int m = 0; m < 4; ++m) { const int row = u.pm * BM + ai * HALF + wr * 64 + m * 16 + fr; const float r = rs[ai][m];
                float o[8];
#pragma unroll
                for (int n = 0; n < 2; ++n)
#pragma unroll
                    for (int e = 0; e < 4; ++e) { const float g = acc[ai][0][m][n][e] * r, uu = acc[ai][1][m][n][e] * r; o[n * 4 + e] = silu_f(g) * uu; }
                u32x4 w; w.x = cvt_pk_bf16(o[0], o[1]); w.y = cvt_pk_bf16(o[2], o[3]); w.z = cvt_pk_bf16(o[4], o[5]); w.w = cvt_pk_bf16(o[6], o[7]);
                *(u32x4*)(O + (size_t)row * ldo + col0) = w; }
    }
};
struct EpiVT {
    static constexpr bool PERM = false, AFTER_DRAIN = false, SWAP = true;
    bf16_t* VT; const float* ss;
    __device__ __forceinline__ void operator()(const f32x4 (&acc)[2][2][4][2], const Unit& u, int wr, int wc, int fr, int fq) const {
        float rs[2][4]; load_rstd(ss, u, wr, fr, fq, rs);
        const int b = u.pm >> 5;
#pragma unroll
        for (int ai = 0; ai < 2; ++ai)
#pragma unroll
            for (int m = 0; m < 4; ++m) {
                float rt[4];
#pragma unroll
                for (int e = 0; e < 4; ++e) rt[e] = __shfl(rs[ai][m], 4 * fq + e);
                const int s0 = (u.pm & 31) * BM + ai * HALF + wr * 64 + m * 16 + 4 * (((fq & 1) << 1) | (fq >> 1));
#pragma unroll
                for (int bj = 0; bj < 2; ++bj)
#pragma unroll
                    for (int n = 0; n < 2; ++n) { const int h = 2 * u.pn + bj, d = wc * 32 + 16 * n + fr; const f32x4 v = acc[ai][bj][m][n];
                        u32x2 w; w.x = cvt_pk_bf16(v[0] * rt[0], v[1] * rt[1]); w.y = cvt_pk_bf16(v[2] * rt[2], v[3] * rt[3]);
                        *(u32x2*)(VT + ((size_t)((b * 8 + h) * 128 + d)) * 8192 + s0) = w; } }
    }
};
template <bool FINAL> struct EpiRes {
    static constexpr bool PERM = true, AFTER_DRAIN = false, SWAP = false;
    bf16_t* xb; float* outf; float* ssout; PG8_LAS float* part;
    __device__ __forceinline__ void operator()(const f32x4 (&acc)[2][2][4][2], const Unit& u, int wr, int wc, int fr, int fq) const {
        const int col0 = u.pn * BM + wc * 32 + 8 * fq;
#pragma unroll
        for (int ai = 0; ai < 2; ++ai) {
            u32x4 bw[4][2]; float qv[4];
#pragma unroll
            for (int m = 0; m < 4; ++m)
#pragma unroll
                for (int bj = 0; bj < 2; ++bj) bw[m][bj] = *(const u32x4*)(xb + (size_t)(u.pm * BM + ai * HALF + wr * 64 + m * 16 + fr) * DM + col0 + bj * HALF);
#pragma unroll
            for (int m = 0; m < 4; ++m) { const int row = u.pm * BM + ai * HALF + wr * 64 + m * 16 + fr; const size_t off = (size_t)row * DM + col0; float q = 0.f;
#pragma unroll
                for (int bj = 0; bj < 2; ++bj) { const u32x4 b = bw[m][bj]; f32x4 v0 = acc[ai][bj][m][0], v1 = acc[ai][bj][m][1];
                    v0[0] += __builtin_bit_cast(float, b.x << 16); v0[1] += __builtin_bit_cast(float, b.x & 0xffff0000u); v0[2] += __builtin_bit_cast(float, b.y << 16); v0[3] += __builtin_bit_cast(float, b.y & 0xffff0000u);
                    v1[0] += __builtin_bit_cast(float, b.z << 16); v1[1] += __builtin_bit_cast(float, b.z & 0xffff0000u); v1[2] += __builtin_bit_cast(float, b.w << 16); v1[3] += __builtin_bit_cast(float, b.w & 0xffff0000u);
                    if (FINAL) { *(f32x4*)(outf + off + bj * HALF) = v0; *(f32x4*)(outf + off + bj * HALF + 4) = v1; }
                    else { u32x4 w; w.x = cvt_pk_bf16(v0[0], v0[1]); w.y = cvt_pk_bf16(v0[2], v0[3]); w.z = cvt_pk_bf16(v1[0], v1[1]); w.w = cvt_pk_bf16(v1[2], v1[3]); *(u32x4*)(xb + off + bj * HALF) = w; }
                    q += ((v0[0] * v0[0] + v0[1] * v0[1]) + (v0[2] * v0[2] + v0[3] * v0[3])) + ((v1[0] * v1[0] + v1[1] * v1[1]) + (v1[2] * v1[2] + v1[3] * v1[3])); }
                q += __shfl_xor(q, 16); q += __shfl_xor(q, 32); qv[m] = q; }
            const float qs = (fq == 0) ? qv[0] : (fq == 1) ? qv[1] : (fq == 2) ? qv[2] : qv[3];
            part[(wr * 4 + wc) * 128 + ai * 64 + 16 * fq + fr] = qs; }
        asm volatile("s_waitcnt lgkmcnt(0)" ::: "memory"); __builtin_amdgcn_s_barrier(); asm volatile("" ::: "memory");
        if (fq < 2) { const int idx = wc * 32 + fq * 16 + fr; const PG8_LAS float* pp = part + wr * 512 + idx;
            const float s = (pp[0] + pp[128]) + (pp[256] + pp[384]);
            ssout[(size_t)u.pn * SSM + (u.pm * BM + (idx >> 6) * HALF + wr * 64 + (idx & 63))] = s; }
    }
};
template <class Epi, class Sched, bool ALIGN_EPI = false, bool SP2 = false>
__device__ __forceinline__ void gemm_phase(PG8_LAS unsigned char* lds, const Gemm g, const Sched& S, const Epi& E) {
    const int tid = threadIdx.x, wid = __builtin_amdgcn_readfirstlane(tid >> 6), lane = tid & 63, wr = wid >> 2, wc = wid & 3, fr = lane & 15, fq = lane >> 4;
    const int K = g.K, nt = K / BK;
    unsigned voffA[2], voffB[2];
#pragma unroll
    for (int i = 0; i < 2; ++i) { int R, C; stage_rc(tid * 16 + i * 8192, R, C); const int Rb = Epi::PERM ? ((R & ~31) + perm32(R & 31)) : R;
        voffA[i] = (unsigned)(R * K + C) * 2u; voffB[i] = (unsigned)(Rb * K + C) * 2u; }
    const size_t kstep = (size_t)(BK * 2);
    const size_t hstep = (size_t)HALF * K * 2;
    const size_t tstep = 2 * hstep;
    const unsigned ldsw = (unsigned)wid * 1024u;
    const int aoff = lds_byte(wr * 64 + fr, fq * 8), boff = lds_byte(wc * 32 + fr, fq * 8);
#define PG8_SA(b, h) (((b) * 2 + (h)) * HTB)
#define PG8_SB(b, h) ((4 + (b) * 2 + (h)) * HTB)
#define PG8_STAGE(bufoff, gbase, voff) do { _Pragma("unroll") for (int _i = 0; _i < 2; ++_i) \
        __builtin_amdgcn_global_load_lds((const unsigned*)((const char*)(gbase) + (voff)[_i]), (PG8_LAS unsigned*)(lds + (bufoff) + ldsw + _i * 8192), 16, 0, 0); } while (0)
#define PG8_LDA(dst, b, h) do { _Pragma("unroll") for (int m = 0; m < 4; ++m) _Pragma("unroll") for (int k = 0; k < 2; ++k) dst[m][k] = *(const PG8_LAS bf16x8*)(lds + PG8_SA(b, h) + aoff + m * 2048 + k * 1024); } while (0)
#define PG8_LDB(dst, b, h) do { _Pragma("unroll") for (int n = 0; n < 2; ++n) _Pragma("unroll") for (int k = 0; k < 2; ++k) dst[n][k] = *(const PG8_LAS bf16x8*)(lds + PG8_SB(b, h) + boff + n * 2048 + k * 1024); } while (0)
#define PG8_MMA(ai, bj, At, Bt) do { __builtin_amdgcn_s_setprio(1); _Pragma("unroll") for (int m = 0; m < 4; ++m) _Pragma("unroll") for (int n = 0; n < 2; ++n) _Pragma("unroll") for (int k = 0; k < 2; ++k) \
        acc[ai][bj][m][n] = Epi::SWAP ? __builtin_amdgcn_mfma_f32_16x16x32_bf16(At[m][k], Bt[n][k], acc[ai][bj][m][n], 0, 0, 0) : __builtin_amdgcn_mfma_f32_16x16x32_bf16(Bt[n][k], At[m][k], acc[ai][bj][m][n], 0, 0, 0); __builtin_amdgcn_s_setprio(0); } while (0)
#define PG8_WAIT_V(n) asm volatile("s_waitcnt vmcnt(" #n ")" ::: "memory")
#define PG8_WAIT_L(n) asm volatile("s_waitcnt lgkmcnt(" #n ")" ::: "memory")
#define PG8_BAR __builtin_amdgcn_s_barrier()
#define PG8_SCHED __builtin_amdgcn_sched_barrier(0)
    Unit cur, nxt; int ui = 0;
    if (!S.next(0, cur)) return;
    f32x4 acc[2][2][4][2];
#pragma unroll
    for (int a = 0; a < 2; ++a)
#pragma unroll
        for (int b = 0; b < 2; ++b)
#pragma unroll
            for (int m = 0; m < 4; ++m)
#pragma unroll
                for (int n = 0; n < 2; ++n) acc[a][b][m][n] = (f32x4){0.f, 0.f, 0.f, 0.f};
    bf16x8 At[4][2], B0[2][2], B1[2][2];
    const char* cA = (const char*)g.A + (size_t)cur.pm * tstep; const char* cB = (const char*)g.Bt + (size_t)cur.pn * tstep;
    S.a_ready(cur);
    if constexpr (SP2) {
        PG8_STAGE(PG8_SB(0, 0), cB, voffB); PG8_STAGE(PG8_SB(0, 1), cB + hstep, voffB); PG8_STAGE(PG8_SA(0, 0), cA, voffA); PG8_STAGE(PG8_SA(0, 1), cA + hstep, voffA);
        if (wr == 1) PG8_BAR;
        PG8_WAIT_V(2); PG8_BAR;
        PG8_STAGE(PG8_SB(1, 0), cB + kstep, voffB); PG8_STAGE(PG8_SA(1, 0), cA + kstep, voffA); PG8_STAGE(PG8_SB(1, 1), cB + hstep + kstep, voffB);
        PG8_WAIT_V(6); PG8_BAR;
    } else {
        PG8_STAGE(PG8_SB(0, 0), cB, voffB); PG8_STAGE(PG8_SA(0, 0), cA, voffA); PG8_STAGE(PG8_SB(0, 1), cB + hstep, voffB); PG8_STAGE(PG8_SA(0, 1), cA + hstep, voffA);
        if (wr == 1) PG8_BAR;
        PG8_WAIT_V(4); PG8_BAR;
        PG8_STAGE(PG8_SB(1, 0), cB + kstep, voffB); PG8_STAGE(PG8_SA(1, 0), cA + kstep, voffA); PG8_STAGE(PG8_SB(1, 1), cB + hstep + kstep, voffB);
        PG8_WAIT_V(6); PG8_BAR;
    }
    for (;;) {
        const bool has_next = S.next(ui + 1, nxt);
        const char* nA = has_next ? (const char*)g.A + (size_t)nxt.pm * tstep : cA; const char* nB = has_next ? (const char*)g.Bt + (size_t)nxt.pn * tstep : cB;
        for (int t = 0; t < nt; t += 2) {
            const bool last = (t == nt - 2);
            const char* a1 = cA + (size_t)(t + 1) * kstep;
            const char* a2 = last ? nA : cA + (size_t)(t + 2) * kstep; const char* b2 = last ? nB : cB + (size_t)(t + 2) * kstep;
            const char* a3 = a2 + kstep; const char* b3 = b2 + kstep;
            if (last && has_next) S.a_ready(nxt);
            if constexpr (SP2) {
            PG8_LDB(B0, 0, 0); PG8_LDB(B1, 0, 1); PG8_SCHED; PG8_LDA(At, 0, 0); PG8_STAGE(PG8_SA(1, 1), a1 + hstep, voffA);
            PG8_WAIT_V(8); PG8_WAIT_L(0); PG8_BAR; PG8_MMA(0, 0, At, B0); PG8_MMA(0, 1, At, B1); PG8_BAR; PG8_SCHED;
            PG8_LDA(At, 0, 1); PG8_STAGE(PG8_SB(0, 0), b2, voffB); PG8_STAGE(PG8_SB(0, 1), b2 + hstep, voffB); PG8_STAGE(PG8_SA(0, 0), a2, voffA);
            PG8_WAIT_V(8); PG8_WAIT_L(0); PG8_BAR; PG8_MMA(1, 0, At, B0); PG8_MMA(1, 1, At, B1); PG8_BAR; PG8_SCHED;
            PG8_LDB(B0, 1, 0); PG8_LDB(B1, 1, 1); PG8_SCHED; PG8_LDA(At, 1, 0); PG8_STAGE(PG8_SA(0, 1), a2 + hstep, voffA);
            PG8_WAIT_V(8); PG8_WAIT_L(0); PG8_BAR; PG8_MMA(0, 0, At, B0); PG8_MMA(0, 1, At, B1); PG8_BAR; PG8_SCHED;
            PG8_LDA(At, 1, 1); PG8_STAGE(PG8_SB(1, 0), b3, voffB); PG8_STAGE(PG8_SB(1, 1), b3 + hstep, voffB); PG8_STAGE(PG8_SA(1, 0), a3, voffA);
            PG8_WAIT_V(8); PG8_WAIT_L(0); PG8_BAR; PG8_MMA(1, 0, At, B0); PG8_MMA(1, 1, At, B1); PG8_BAR; PG8_SCHED;
            } else {
            PG8_LDB(B0, 0, 0); PG8_SCHED; PG8_LDA(At, 0, 0); PG8_STAGE(PG8_SA(1, 1), a1 + hstep, voffA);
            PG8_WAIT_L(8); PG8_BAR; PG8_WAIT_L(0); PG8_MMA(0, 0, At, B0); PG8_BAR; PG8_SCHED;
            PG8_LDB(B1, 0, 1); PG8_STAGE(PG8_SB(0, 0), b2, voffB);
            PG8_BAR; PG8_WAIT_L(0); PG8_MMA(0, 1, At, B1); PG8_BAR;
            PG8_LDA(At, 0, 1); PG8_STAGE(PG8_SA(0, 0), a2, voffA);
            PG8_BAR; PG8_WAIT_L(0); PG8_MMA(1, 0, At, B0); PG8_BAR; PG8_SCHED;
            PG8_STAGE(PG8_SB(0, 1), b2 + hstep, voffB);
            PG8_WAIT_V(6); PG8_BAR; PG8_MMA(1, 1, At, B1); PG8_BAR;
            PG8_LDB(B0, 1, 0); PG8_SCHED; PG8_LDA(At, 1, 0); PG8_STAGE(PG8_SA(0, 1), a2 + hstep, voffA);
            PG8_WAIT_L(8); PG8_BAR; PG8_WAIT_L(0); PG8_MMA(0, 0, At, B0); PG8_BAR; PG8_SCHED;
            PG8_LDB(B1, 1, 1); PG8_STAGE(PG8_SB(1, 0), b3, voffB);
            PG8_BAR; PG8_WAIT_L(0); PG8_MMA(0, 1, At, B1); PG8_BAR;
            PG8_LDA(At, 1, 1); PG8_STAGE(PG8_SA(1, 0), a3, voffA);
            PG8_BAR; PG8_WAIT_L(0); PG8_MMA(1, 0, At, B0); PG8_BAR; PG8_SCHED;
            PG8_STAGE(PG8_SB(1, 1), b3 + hstep, voffB);
            PG8_WAIT_V(6); PG8_BAR; PG8_MMA(1, 1, At, B1); PG8_BAR;
            }
        }
        if constexpr (ALIGN_EPI) { if (wr == 0) PG8_BAR; }
        if constexpr (!Epi::AFTER_DRAIN) { E(acc, cur, wr, wc, fr, fq); S.done(cur); }
        if (!has_next) break;
#pragma unroll
        for (int a = 0; a < 2; ++a)
#pragma unroll
            for (int b = 0; b < 2; ++b)
#pragma unroll
                for (int m = 0; m < 4; ++m)
#pragma unroll
                    for (int n = 0; n < 2; ++n) acc[a][b][m][n] = (f32x4){0.f, 0.f, 0.f, 0.f};
        cur = nxt; cA = nA; cB = nB; ++ui;
        if constexpr (ALIGN_EPI) { if (wr == 1) PG8_BAR; }
    }
    PG8_WAIT_V(0);
    if constexpr (!ALIGN_EPI) { if (wr == 0) PG8_BAR; }
    PG8_BAR;
    if constexpr (Epi::AFTER_DRAIN) { E.fused(acc, cur, wr, wc, fr, fq, lds, wid, lane); S.done(cur); }
#undef PG8_SA
#undef PG8_SB
#undef PG8_STAGE
#undef PG8_LDA
#undef PG8_LDB
#undef PG8_MMA
#undef PG8_WAIT_V
#undef PG8_WAIT_L
#undef PG8_BAR
#undef PG8_SCHED
}
}

#define LAS __attribute__((address_space(3)))
typedef unsigned short bf16;
typedef float f32x4 __attribute__((ext_vector_type(4)));
typedef float f32x16 __attribute__((ext_vector_type(16)));
typedef short bf16x8 __attribute__((ext_vector_type(8)));
typedef unsigned u32x4 __attribute__((ext_vector_type(4)));
typedef unsigned u32x2 __attribute__((ext_vector_type(2)));
constexpr int BATCH = 4, SEQ = 8192, D = 1024, M = BATCH * SEQ, FF = 2816, NH = 8;
constexpr size_t MiB = 1u << 20;
constexpr size_t WS_WIN = 0, WS_WOUT = 4 * MiB, WS_WGU0 = 6 * MiB, WS_WGU1 = 17 * MiB, WS_WDN0 = 28 * MiB, WS_WDN1 = 34 * MiB, WS_WQKV = 40 * MiB, WS_WO = 46 * MiB, WS_WSP = 48 * MiB;
constexpr size_t WS_SS = 50 * MiB;
constexpr size_t WS_CTL = 60 * MiB;
constexpr size_t WS_BAR = 61 * MiB;
constexpr size_t WS_XB = 64 * MiB;
constexpr size_t WS_R1 = 128 * MiB, WS_R2 = 192 * MiB, WS_R3 = 256 * MiB;
constexpr size_t WS_O = 320 * MiB, WS_END = 384 * MiB;
constexpr int NWAVES = 8, NTHR = 512;
constexpr int LDS_BYTES = 147456;
constexpr float LOG2E = 1.4426950408889634f;
constexpr float LAMBDA_INIT = 0.35550906f;

__device__ __forceinline__ unsigned pk2(float lo, float hi) { return pg8::cvt_pk_bf16(lo, hi); }
__device__ __forceinline__ float bf2f(unsigned short h) { return __builtin_bit_cast(float, (unsigned)h << 16); }
__device__ __forceinline__ float bflo(unsigned w) { return __builtin_bit_cast(float, w << 16); }
__device__ __forceinline__ float bfhi(unsigned w) { return __builtin_bit_cast(float, w & 0xffff0000u); }
__device__ __forceinline__ float wave_sum(float v) {
#pragma unroll
    for (int o = 1; o < 64; o <<= 1) v += __shfl_xor(v, o);
    return v;
}

struct ConvD { const float* W; int K, N; bf16* WT; int row_off, mode; const float* gain; int gmask; float scale; int item; };
__device__ __forceinline__ void conv_load(const ConvD& d, int lane, f32x4 (&wv)[8]) {
    const int nblk = d.N / 32, kb = d.item / nblk, nb = d.item % nblk, k0 = 64 * kb, n0 = 32 * nb;
#pragma unroll
    for (int i = 0; i < 8; ++i) wv[i] = __builtin_nontemporal_load((const f32x4*)(d.W + (size_t)(k0 + 8 * i + (lane >> 3)) * d.N + n0 + 4 * (lane & 7)));
}
__device__ __forceinline__ void conv_fin(const ConvD& d, const f32x4 (&wv)[8], LAS float* scr, int lane) {
    const int nblk = d.N / 32, kb = d.item / nblk, nb = d.item % nblk, k0 = 64 * kb, n0 = 32 * nb;
#pragma unroll
    for (int i = 0; i < 8; ++i) { const int kk = 8 * i + (lane >> 3); const float g = d.gain ? d.gain[(k0 + kk) & d.gmask] * d.scale : d.scale;
        LAS float* p = scr + kk * 33 + 4 * (lane & 7); p[0] = wv[i][0] * g; p[1] = wv[i][1] * g; p[2] = wv[i][2] * g; p[3] = wv[i][3] * g; }
    asm volatile("s_waitcnt lgkmcnt(0)" ::: "memory");
    int rbase;
    if (d.mode == 0) rbase = d.row_off + n0; else { const int nn = (n0 < FF) ? n0 : n0 - FF; rbase = (nn >> 7) * 256 + (nn & 127) + ((n0 < FF) ? 0 : 128); }
    const int c = lane & 7;
#pragma unroll
    for (int j = 0; j < 4; ++j) { const int n = (lane >> 3) + 8 * j; const LAS float* s = scr + (8 * c) * 33 + n;
        u32x4 o; o.x = pk2(s[0 * 33], s[1 * 33]); o.y = pk2(s[2 * 33], s[3 * 33]); o.z = pk2(s[4 * 33], s[5 * 33]); o.w = pk2(s[6 * 33], s[7 * 33]);
        *(u32x4*)(d.WT + (size_t)(rbase + n) * d.K + k0 + 8 * c) = o; }
    asm volatile("s_waitcnt lgkmcnt(0)" ::: "memory");
}

struct Ptrs {
    const float* in[18]; float* out; unsigned char* ws; int ph_lo, ph_hi;
};

__device__ __forceinline__ void p0_prologue(const Ptrs& P, LAS unsigned char* lds, int vcu, int G, int wave, int lane, int tid) {
    LAS float* scr = (LAS float*)(lds + wave * 16384);
    const int gw = vcu * NWAVES + wave, NGW = G * NWAVES;
    unsigned char* ws = P.ws;
    constexpr int I_WIN = 16 * 64, I_WOUT = 16 * 32, I_GU = 16 * 176, I_DN = 44 * 32, I_Q = 16 * 32, I_KV = 16 * 64, I_O = 16 * 32;
    constexpr int NITEMS = I_WIN + I_WOUT + 2 * I_GU + 2 * I_DN + I_Q + I_KV + I_O;
    auto desc = [&](int it) -> ConvD {
        int r = it;
        if (r < I_WIN) return ConvD{P.in[2], D, 2 * D, (bf16*)(ws + WS_WIN), 0, 0, P.in[1], 1023, 1.f, r}; r -= I_WIN;
        if (r < I_WOUT) return ConvD{P.in[6], D, D, (bf16*)(ws + WS_WOUT), 0, 0, nullptr, 0, 1.f, r}; r -= I_WOUT;
        if (r < I_GU) return ConvD{P.in[8], D, 2 * FF, (bf16*)(ws + WS_WGU0), 0, 1, P.in[7], 1023, 1.f, r}; r -= I_GU;
        if (r < I_GU) return ConvD{P.in[8] + (size_t)D * 2 * FF, D, 2 * FF, (bf16*)(ws + WS_WGU1), 0, 1, P.in[7] + D, 1023, 1.f, r}; r -= I_GU;
        if (r < I_DN) return ConvD{P.in[9], FF, D, (bf16*)(ws + WS_WDN0), 0, 0, nullptr, 0, 1.f, r}; r -= I_DN;
        if (r < I_DN) return ConvD{P.in[9] + (size_t)FF * D, FF, D, (bf16*)(ws + WS_WDN1), 0, 0, nullptr, 0, 1.f, r}; r -= I_DN;
        if (r < I_Q) return ConvD{P.in[13], D, D, (bf16*)(ws + WS_WQKV), 0, 0, P.in[12], 1023, 0.125f * LOG2E, r}; r -= I_Q;
        if (r < I_KV) return ConvD{P.in[11], D, 2 * D, (bf16*)(ws + WS_WQKV), D, 0, P.in[10], 1023, 1.f, r}; r -= I_KV;
        return ConvD{P.in[16], D, D, (bf16*)(ws + WS_WO), 0, 0, P.in[15], 127, 1.0f - LAMBDA_INIT, r};
    };
    if (gw < NITEMS) { int it = gw; ConvD dA = desc(it), dB = dA; f32x4 wA[8], wB[8]; conv_load(dA, lane, wA);
        for (;;) { const int itB = it + NGW; const bool hb = itB < NITEMS; if (hb) { dB = desc(itB); conv_load(dB, lane, wB); }
            conv_fin(dA, wA, scr, lane); if (!hb) break;
            const int itA = itB + NGW; const bool ha = itA < NITEMS; if (ha) { dA = desc(itA); conv_load(dA, lane, wA); }
            conv_fin(dB, wB, scr, lane); if (!ha) break; it = itA; } }
    if (vcu == 0) { unsigned* ctl = (unsigned*)(ws + WS_CTL); if (tid < 128) ctl[tid] = 0u; if (tid < 8) ctl[1024 + 32 * tid] = 0u; }
    { bf16* wsp = (bf16*)(ws + WS_WSP); const float* w = P.in[4];
      for (int i = vcu * NTHR + tid; i < 8 * 128 * 128; i += G * NTHR) { const int t = (i >> 7) & 127, s = i & 127; wsp[i] = (bf16)(pk2(s <= t ? w[i] : 0.f, 0.f) & 0xffffu); } }
    { const float* x = P.in[0]; bf16* xb = (bf16*)(ws + WS_XB); float* ss0 = (float*)(ws + WS_SS);
      for (int m0 = gw * 16; m0 < M; m0 += NGW * 16) { float mine = 0.f;
          for (int k2 = 0; k2 < 16; k2 += 2) {
          f32x4 v[2][4];
#pragma unroll
          for (int u = 0; u < 2; ++u) { const f32x4* xr = (const f32x4*)(x + (size_t)(m0 + k2 + u) * D) + lane;
#pragma unroll
              for (int j = 0; j < 4; ++j) v[u][j] = __builtin_nontemporal_load(xr + 64 * j); }
#pragma unroll
          for (int u = 0; u < 2; ++u) { const int m = m0 + k2 + u; float s = 0.f;
#pragma unroll
              for (int j = 0; j < 4; ++j) s += (v[u][j][0] * v[u][j][0] + v[u][j][1] * v[u][j][1]) + (v[u][j][2] * v[u][j][2] + v[u][j][3] * v[u][j][3]);
              s = wave_sum(s);
              u32x2* o8 = (u32x2*)(xb + (size_t)m * D) + lane;
#pragma unroll
              for (int j = 0; j < 4; ++j) { u32x2 w; w.x = pk2(v[u][j][0], v[u][j][1]); w.y = pk2(v[u][j][2], v[u][j][3]); o8[64 * j] = w; }
              if (lane == k2 + u) mine = s; } }
          if (lane < 16) { ss0[m0 + lane] = mine;
#pragma unroll
              for (int j = 1; j < 4; ++j) ss0[(size_t)j * M + m0 + lane] = 0.f; }
      } }
}

constexpr int SP_PITCH = 184;
__device__ __forceinline__ void spatial_phase(LAS unsigned char* lds, const bf16* U, const bf16* VV, const bf16* WSP, const float* vgain, const float* bsp, bf16* UZ, int vcu, int G, int wave, int lane, int tid) {
    LAS bf16* vt = (LAS bf16*)lds;
    LAS float* mu_s = (LAS float*)(lds + 49152); LAS float* rs_s = mu_s + 128;
    const int l31 = lane & 31, hi = lane >> 5, dblk = wave & 3, pp = wave >> 2;
    for (int unit = vcu; unit < M / 128; unit += G) {
        const int tok0 = unit * 128;
        for (int rr = 0; rr < 16; ++rr) { const int s = wave * 16 + rr; const bf16* rp = VV + (size_t)(tok0 + s) * D;
            const u32x4 a = *(const u32x4*)(rp + lane * 8), b = *(const u32x4*)(rp + 512 + lane * 8);
            float f[16]; f[0] = bflo(a.x); f[1] = bfhi(a.x); f[2] = bflo(a.y); f[3] = bfhi(a.y); f[4] = bflo(a.z); f[5] = bfhi(a.z); f[6] = bflo(a.w); f[7] = bfhi(a.w);
            f[8] = bflo(b.x); f[9] = bfhi(b.x); f[10] = bflo(b.y); f[11] = bfhi(b.y); f[12] = bflo(b.z); f[13] = bfhi(b.z); f[14] = bflo(b.w); f[15] = bfhi(b.w);
            float sm = 0.f;
#pragma unroll
            for (int j = 0; j < 16; ++j) sm += f[j];
            const float mean = wave_sum(sm) * (1.0f / D); float q = 0.f;
#pragma unroll
            for (int j = 0; j < 16; ++j) { const float d = f[j] - mean; q += d * d; }
            const float var = wave_sum(q) * (1.0f / D);
            if (lane == 0) { mu_s[s] = mean; rs_s[s] = rsqrtf(var + 1e-6f); } }
        __syncthreads();
        for (int g = 0; g < 8; ++g) {
            const int s = tid >> 2, dp = tid & 3; const bf16* rp = VV + (size_t)(tok0 + s) * D + g * 128;
            u32x4 vp4[4];
#pragma unroll
            for (int i = 0; i < 4; ++i) vp4[i] = *(const u32x4*)(rp + i * 32 + dp * 8);
            bf16x8 wf[2][8]; u32x2 uu[2][4]; float bias[2];
#pragma unroll
            for (int sel = 0; sel < 2; ++sel) { const int tb = sel ? 3 - pp : pp; const bf16* bp = WSP + ((size_t)(g * 128 + tb * 32 + l31)) * 128 + 8 * hi;
#pragma unroll
                for (int ks = 0; ks < 8; ++ks) { if (ks < 2 * (tb + 1)) wf[sel][ks] = *(const bf16x8*)(bp + 16 * ks); else wf[sel][ks] = (bf16x8){0, 0, 0, 0, 0, 0, 0, 0}; }
                const int t = tb * 32 + l31; bias[sel] = bsp[g * 128 + t]; const size_t ro = (size_t)(tok0 + t) * D + g * 128 + dblk * 32 + 4 * hi;
#pragma unroll
                for (int q4 = 0; q4 < 4; ++q4) uu[sel][q4] = *(const u32x2*)(U + ro + 8 * q4); }
            { const float mu = mu_s[s], rs = rs_s[s];
#pragma unroll
              for (int i = 0; i < 4; ++i) { const int c = i * 32 + dp * 8; const u32x4 a = vp4[i];
                  const f32x4 g0 = *(const f32x4*)(vgain + g * 128 + c), g1 = *(const f32x4*)(vgain + g * 128 + c + 4);
                  float f[8]; f[0] = bflo(a.x); f[1] = bfhi(a.x); f[2] = bflo(a.y); f[3] = bfhi(a.y); f[4] = bflo(a.z); f[5] = bfhi(a.z); f[6] = bflo(a.w); f[7] = bfhi(a.w);
#pragma unroll
                  for (int j = 0; j < 8; ++j) { const float gg = (j < 4) ? g0[j & 3] : g1[j & 3]; const float v = (f[j] - mu) * rs * gg; vt[(c + j) * SP_PITCH + 16 * dp + s] = (bf16)(pk2(v, 0.f) & 0xffffu); } } }
            __syncthreads();
#pragma unroll
            for (int sel = 0; sel < 2; ++sel) { const int tb = sel ? 3 - pp : pp; const int nks = 2 * (tb + 1);
                f32x16 acc = {};
                const LAS bf16* ap = vt + (dblk * 32 + l31) * SP_PITCH + 16 * ((l31 >> 3) & 3) + 8 * hi;
#pragma unroll
                for (int ks = 0; ks < 8; ++ks) { if (ks < nks) { const bf16x8 a = *(const LAS bf16x8*)(ap + 16 * ks); acc = __builtin_amdgcn_mfma_f32_32x32x16_bf16(a, wf[sel][ks], acc, 0, 0, 0); } }
                const int t = tb * 32 + l31; const size_t ro = (size_t)(tok0 + t) * D + g * 128 + dblk * 32 + 4 * hi; const float bs = bias[sel];
#pragma unroll
                for (int q4 = 0; q4 < 4; ++q4) { const u32x2 u2 = uu[sel][q4];
                    const float z0 = acc[4 * q4 + 0] + bs, z1 = acc[4 * q4 + 1] + bs, z2 = acc[4 * q4 + 2] + bs, z3 = acc[4 * q4 + 3] + bs;
                    u32x2 w; w.x = pk2(bflo(u2.x) * z0, bfhi(u2.x) * z1); w.y = pk2(bflo(u2.y) * z2, bfhi(u2.y) * z3); *(u32x2*)(UZ + ro + 8 * q4) = w; } }
            __syncthreads();
        }
    }
}
constexpr int AT_KP = 136, AT_VP = 72, AT_KBYTES = 64 * AT_KP * 2, AT_VBYTES = 128 * AT_VP * 2;
constexpr int AT_VOFF = 2 * AT_KBYTES;
constexpr int AT_FLAG = 73728;
constexpr float AT_THR = 6.0f;
__device__ __forceinline__ int crow(int r, int hi) { return (r & 3) + 8 * (r >> 2) + 4 * hi; }
__device__ __forceinline__ float max3f(float a, float b, float c) { float r; asm("v_max3_f32 %0, %1, %2, %3" : "=v"(r) : "v"(a), "v"(b), "v"(c)); return r; }
__device__ __forceinline__ float xhalf_max(float v) { auto rr = __builtin_amdgcn_permlane32_swap(__float_as_uint(v), __float_as_uint(v), false, false); return fmaxf(__uint_as_float(rr[0]), __uint_as_float(rr[1])); }
__device__ __forceinline__ float xhalf_sum(float v) { auto rr = __builtin_amdgcn_permlane32_swap(__float_as_uint(v), __float_as_uint(v), false, false); return __uint_as_float(rr[0]) + __uint_as_float(rr[1]); }
constexpr float AT_STOP = 32.0f;
__device__ __forceinline__ void attn_unit(LAS unsigned char* lds, const bf16* Q, const bf16* K, const bf16* VT, bf16* O, const float* KN, int b, int h, int qb, float lam, int wave, int lane, int tid) {
    const int rg = wave & 3, mp = wave >> 2, l31 = lane & 31, hi = lane >> 5;
    const int q0 = qb * 128, NT = 2 * (qb + 1);
    const size_t rowbase = (size_t)b * SEQ;
    const float slope2 = exp2f(-(float)(h + 1)) * LOG2E;
    const int qrel = 32 * rg + l31;
    bf16x8 qf[4];
    float ub;
    { const bf16* qp = Q + (rowbase + q0 + qrel) * D + h * 128 + mp * 64 + 8 * hi; float qs = 0.f;
#pragma unroll
      for (int ks = 0; ks < 4; ++ks) { qf[ks] = *(const bf16x8*)(qp + 16 * ks);
#pragma unroll
          for (int e = 0; e < 8; ++e) { const float v = bf2f((unsigned short)qf[ks][e]); qs += v * v; } }
      qs = xhalf_sum(qs);
      const float* kn = KN + ((b * 8 + h) * 2 + mp) * 2; const float k2 = kn[0] + kn[1];
      ub = sqrtf(qs * k2) * 1.002f + 1e-3f; }
    f32x16 o[4];
#pragma unroll
    for (int i = 0; i < 4; ++i) o[i] = (f32x16){};
    float mref = 0.f, lrun = 0.f; bool inited = false;
    const bool lean = (__all(2.f * ub + AT_THR < 100.f) != 0);
    const float abl = slope2 * (float)(4 * hi - qrel);
    const bf16* kg0 = K + (rowbase + q0 + 64 + (tid >> 4)) * D + h * 128 + (tid & 15) * 8;
    const bf16* vg0 = VT + ((size_t)((b * 8 + h) * 128 + (tid >> 3))) * SEQ + q0 + 64 + (tid & 7) * 8;
    const int kl0 = ((tid >> 4) * AT_KP + (tid & 15) * 8) * 2, vl0 = ((tid >> 3) * AT_VP + (tid & 7) * 8) * 2;
    LAS unsigned* flags = (LAS unsigned*)(lds + AT_FLAG);
    u32x4 kr0, kr1, vr0, vr1;
#define AT_LDK(j) do { const bf16* p_ = kg0 - (size_t)(j) * 64 * D; kr0 = *(const u32x4*)p_; kr1 = *(const u32x4*)(p_ + 32 * D); } while (0)
#define AT_LDV(j) do { const bf16* p_ = vg0 - (size_t)(j) * 64; vr0 = *(const u32x4*)p_; vr1 = *(const u32x4*)(p_ + (size_t)64 * SEQ); } while (0)
#define AT_STK(slot) do { *(LAS u32x4*)(lds + (slot) * AT_KBYTES + kl0) = kr0; *(LAS u32x4*)(lds + (slot) * AT_KBYTES + kl0 + 32 * AT_KP * 2) = kr1; } while (0)
#define AT_STV(slot) do { *(LAS u32x4*)(lds + AT_VOFF + (slot) * AT_VBYTES + vl0) = vr0; *(LAS u32x4*)(lds + AT_VOFF + (slot) * AT_VBYTES + vl0 + 64 * AT_VP * 2) = vr1; } while (0)
#define AT_QK(S0, S1, j) do { const float c_ = (slope2 * (float)(64 - 64 * (j)) - mref) + abl; const float c1_ = c_ + 32.f * slope2; \
        const LAS bf16* kb_ = (const LAS bf16*)(lds + ((j) & 1) * AT_KBYTES) + l31 * AT_KP + mp * 64 + 8 * hi; \
        bf16x8 ka_[4], kc_[4]; \
        _Pragma("unroll") for (int ks = 0; ks < 4; ++ks) { ka_[ks] = *(const LAS bf16x8*)(kb_ + 16 * ks); kc_[ks] = *(const LAS bf16x8*)(kb_ + 32 * AT_KP + 16 * ks); } \
        _Pragma("unroll") for (int r = 0; r < 16; ++r) { const float sk_ = slope2 * (float)crow(r, 0); S0[r] = c_ + sk_; S1[r] = c1_ + sk_; } \
        __builtin_amdgcn_sched_barrier(0); __builtin_amdgcn_s_setprio(1); \
        _Pragma("unroll") for (int ks = 0; ks < 4; ++ks) { \
            S0 = __builtin_amdgcn_mfma_f32_32x32x16_bf16(ka_[ks], qf[ks], S0, 0, 0, 0); S1 = __builtin_amdgcn_mfma_f32_32x32x16_bf16(kc_[ks], qf[ks], S1, 0, 0, 0); } __builtin_amdgcn_s_setprio(0); } while (0)
#define AT_VRD(dst, kk) do { _Pragma("unroll") for (int i = 0; i < 4; ++i) dst[i] = *(const LAS bf16x8*)(vb + i * 32 * AT_VP + 16 * (kk)); } while (0)
#define AT_PVM(src, kk) do { __builtin_amdgcn_s_setprio(1); _Pragma("unroll") for (int i = 0; i < 4; ++i) o[i] = __builtin_amdgcn_mfma_f32_32x32x16_bf16(src[i], __builtin_bit_cast(bf16x8, pk[kk]), o[i], 0, 0, 0); __builtin_amdgcn_s_setprio(0); } while (0)
    AT_LDK(0); AT_STK(0); AT_LDV(0); AT_STV(0);
    __syncthreads();
    for (int j = 0; j < NT; ++j) {
        const bool hasn = (j + 1 < NT);
        if (hasn) { AT_LDK(j + 1); AT_LDV(j + 1); }
        u32x4 fa = (u32x4){0u, 0u, 0u, 0u}, fb = fa;
        if (j > 0) { const LAS u32x4* fp = (const LAS u32x4*)(flags + ((j - 1) & 1) * 8); fa = fp[0]; fb = fp[1]; }
        f32x16 c0, c1;
        AT_QK(c0, c1, j);
        if ((fa.x & fa.y & fa.z & fa.w & fb.x & fb.y & fb.z & fb.w) != 0u) break;
        const LAS bf16* vb = (const LAS bf16*)(lds + AT_VOFF + (j & 1) * AT_VBYTES) + l31 * AT_VP + 8 * hi;
        bf16x8 vA[4], vB[4];
        AT_VRD(vA, 0);
        if (j < 2 || !lean) {
        if (j < 2) { const int kvb = 64 - 64 * j;
#pragma unroll
            for (int r = 0; r < 16; ++r) { const int kv = kvb + crow(r, hi); if (kv > qrel) c0[r] = -INFINITY; if (kv + 32 > qrel) c1[r] = -INFINITY; } }
        float mx = max3f(c0[0], c1[0], c0[1]), mx2 = max3f(c1[1], c0[2], c1[2]);
#pragma unroll
        for (int r = 3; r < 15; r += 2) { mx = max3f(mx, c0[r], c1[r]); mx2 = max3f(mx2, c0[r + 1], c1[r + 1]); }
        mx = xhalf_max(max3f(mx, mx2, fmaxf(c0[15], c1[15])));
        const bool need = (mx > AT_THR) || (!inited && mx > -1e30f);
        if (__any(need)) { const float dl = need ? mx : 0.f; const float f = (need && inited) ? __builtin_amdgcn_exp2f(-dl) : 1.f;
            mref += dl; lrun *= f; inited = inited || need;
#pragma unroll
            for (int r = 0; r < 16; ++r) { c0[r] -= dl; c1[r] -= dl; }
#pragma unroll
            for (int i = 0; i < 4; ++i) {
#pragma unroll
                for (int r = 0; r < 16; ++r) o[i][r] *= f; } }
        }
        { const bool can = inited && (ub - slope2 * (float)(qrel + 64 * j - 63) - mref < -AT_STOP);
          const bool wv = (__all(can) != 0) && (j >= 1);
          if (lane == 0) flags[(j & 1) * 8 + wave] = wv ? 1u : 0u; }
        float ls = 0.f;
#pragma unroll
        for (int r = 0; r < 16; ++r) { c0[r] = __builtin_amdgcn_exp2f(c0[r]); c1[r] = __builtin_amdgcn_exp2f(c1[r]); ls += c0[r] + c1[r]; }
        lrun += ls;
        u32x4 pk[4];
#pragma unroll
        for (int s = 0; s < 2; ++s) {
            pk[s]     = (u32x4){pk2(c0[8 * s + 0], c0[8 * s + 1]), pk2(c0[8 * s + 2], c0[8 * s + 3]), pk2(c0[8 * s + 4], c0[8 * s + 5]), pk2(c0[8 * s + 6], c0[8 * s + 7])};
            pk[2 + s] = (u32x4){pk2(c1[8 * s + 0], c1[8 * s + 1]), pk2(c1[8 * s + 2], c1[8 * s + 3]), pk2(c1[8 * s + 4], c1[8 * s + 5]), pk2(c1[8 * s + 6], c1[8 * s + 7])}; }
        __builtin_amdgcn_sched_barrier(0);
        AT_VRD(vB, 1); __builtin_amdgcn_sched_barrier(0); AT_PVM(vA, 0); __builtin_amdgcn_sched_barrier(0);
        AT_VRD(vA, 2); __builtin_amdgcn_sched_barrier(0); AT_PVM(vB, 1); __builtin_amdgcn_sched_barrier(0);
        AT_VRD(vB, 3); __builtin_amdgcn_sched_barrier(0); AT_PVM(vA, 2); __builtin_amdgcn_sched_barrier(0);
        AT_PVM(vB, 3);
        if (hasn) { AT_STK((j + 1) & 1); AT_STV((j + 1) & 1); }
        __syncthreads();
    }
#undef AT_LDK
#undef AT_LDV
#undef AT_STK
#undef AT_STV
#undef AT_QK
#undef AT_VRD
#undef AT_PVM
    lrun = xhalf_sum(lrun);
    const float inv = 1.0f / lrun;
    LAS float* ex = (LAS float*)lds + (size_t)rg * 64 * 64;
    if (mp == 1) { const float sc = lam * inv;
#pragma unroll
        for (int i = 0; i < 4; ++i)
#pragma unroll
            for (int r = 0; r < 16; ++r) ex[(i * 16 + r) * 64 + lane] = o[i][r] * sc; }
    __syncthreads();
    if (mp == 0) { float ssq = 0.f;
#pragma unroll
        for (int i = 0; i < 4; ++i)
#pragma unroll
            for (int r = 0; r < 16; ++r) { const float v = o[i][r] * inv - ex[(i * 16 + r) * 64 + lane]; o[i][r] = v; ssq += v * v; }
        ssq = xhalf_sum(ssq);
        const float rn = rsqrtf(ssq * (1.0f / 128.0f) + 1e-6f);
        bf16* op = O + (rowbase + q0 + qrel) * D + h * 128 + 4 * hi;
#pragma unroll
        for (int i = 0; i < 4; ++i)
#pragma unroll
            for (int q4 = 0; q4 < 4; ++q4) { u32x2 w; w.x = pk2(o[i][4 * q4] * rn, o[i][4 * q4 + 1] * rn); w.y = pk2(o[i][4 * q4 + 2] * rn, o[i][4 * q4 + 3] * rn);
                *(u32x2*)(op + i * 32 + 8 * q4) = w; } }
    __syncthreads();
}
__device__ __forceinline__ int attn_fetch(unsigned* ctr, int myq) {
    for (int t = 0; t < 8; ++t) { const int q = (myq + t) & 7; const unsigned idx = __hip_atomic_fetch_add(ctr + 32 * q, 1u, __ATOMIC_RELAXED, __HIP_MEMORY_SCOPE_AGENT); if (idx < 256u) return q * 256 + (int)idx; }
    return -1;
}
__device__ __forceinline__ void attn_phase(LAS unsigned char* lds, const bf16* Q, const bf16* K, const bf16* VT, bf16* O, const float* lamv, const float* KN, unsigned* ctr, int wave, int lane, int tid) {
    const float a = wave_sum(lamv[lane] * lamv[64 + lane]), c = wave_sum(lamv[128 + lane] * lamv[192 + lane]);
    const float lam = expf(a) - expf(c) + LAMBDA_INIT;
    LAS int* itemw = (LAS int*)(lds + AT_FLAG + 64);
    const int myq = blockIdx.x & 7;
    if (tid == 0) *itemw = attn_fetch(ctr, myq);
    __syncthreads();
    for (;;) {
        const int item = *itemw;
        if (item < 0) break;
        const int q = item >> 8, idx = item & 255, hs = idx >> 6, qb = 63 - (idx & 63);
        const int h = (q & 1) ? ((hs == 0) ? 6 : (hs == 1) ? 5 : (hs == 2) ? 2 : 1) : ((hs == 0) ? 7 : (hs == 1) ? 4 : (hs == 2) ? 3 : 0);
        unsigned pre = 0u;
        if (tid == 0) pre = __hip_atomic_fetch_add(ctr + 32 * myq, 1u, __ATOMIC_RELAXED, __HIP_MEMORY_SCOPE_AGENT);
        attn_unit(lds, Q, K, VT, O, KN, q >> 1, h, qb, lam, wave, lane, tid);
        if (tid == 0) *itemw = (pre < 256u) ? (myq * 256 + (int)pre) : attn_fetch(ctr, myq + 1);
        __syncthreads();
    }
}

__device__ __forceinline__ void final_phase(const bf16* xb, float* out, const float* ss, const float* gain, int vcu, int G, int wave, int lane) {
    const int gw = vcu * NWAVES + wave, NGW = G * NWAVES;
    f32x4 g[4];
#pragma unroll
    for (int j = 0; j < 2; ++j) { g[2 * j] = *(const f32x4*)(gain + 512 * j + 8 * lane); g[2 * j + 1] = *(const f32x4*)(gain + 512 * j + 8 * lane + 4); }
    for (int m = gw; m < M; m += NGW) {
        float sl = ss[(size_t)(lane & 3) * 32768 + m]; sl += __shfl_xor(sl, 1); sl += __shfl_xor(sl, 2);
        const u32x4 w0 = *(const u32x4*)(xb + (size_t)m * D + 8 * lane), w1 = *(const u32x4*)(xb + (size_t)m * D + 512 + 8 * lane);
        const float r = rsqrtf(sl * (1.0f / D) + 1e-6f);
        float* orow = out + (size_t)m * D + 8 * lane;
        __builtin_nontemporal_store((f32x4)((f32x4){bflo(w0.x), bfhi(w0.x), bflo(w0.y), bfhi(w0.y)} * r * g[0]), (f32x4*)(orow));
        __builtin_nontemporal_store((f32x4)((f32x4){bflo(w0.z), bfhi(w0.z), bflo(w0.w), bfhi(w0.w)} * r * g[1]), (f32x4*)(orow + 4));
        __builtin_nontemporal_store((f32x4)((f32x4){bflo(w1.x), bfhi(w1.x), bflo(w1.y), bfhi(w1.y)} * r * g[2]), (f32x4*)(orow + 512));
        __builtin_nontemporal_store((f32x4)((f32x4){bflo(w1.z), bfhi(w1.z), bflo(w1.w), bfhi(w1.w)} * r * g[3]), (f32x4*)(orow + 516));
    }
}

#define XB_TMO      128
#define XB_XCNT(j)  (256  + 64 * (j))
#define XB_XSUB(j)  (1280 + 64 * (j))
#define XB_XGEN(j)  (2304 + 64 * (j))
#define XB_TOP      3328
#define XB_TOPGEN   3392
#define XCD_BAR_WORDS 3456
#define XB_SPIN_CAP (1u << 18)

__device__ __forceinline__ unsigned xb_ld(unsigned* p)              { return __hip_atomic_load(p, __ATOMIC_RELAXED, __HIP_MEMORY_SCOPE_AGENT); }
__device__ __forceinline__ unsigned xb_add(unsigned* p, unsigned v) { return __hip_atomic_fetch_add(p, v, __ATOMIC_RELAXED, __HIP_MEMORY_SCOPE_AGENT); }
__device__ __forceinline__ unsigned xb_xcc_id() { return (unsigned)__builtin_amdgcn_s_getreg((3 << 11) | 20) & 0xFu; }
#define XB_SPIN(cond, bar) do { unsigned _sp = 0; while (cond) { __builtin_amdgcn_s_sleep(1); \
    if ((++_sp & 255u) == 0u) { if (xb_ld(&(bar)[XB_TMO])) break; if (_sp > XB_SPIN_CAP) { atomicAdd(&(bar)[XB_TMO], 1u); break; } } } } while (0)

struct XcdBarrier {
    unsigned* bar; unsigned x;
    volatile LAS unsigned* st;
};

__device__ __forceinline__ XcdBarrier xcd_barrier_post(unsigned* bar, volatile LAS unsigned* st) {
    XcdBarrier b; b.bar = bar; b.x = xb_xcc_id(); b.st = st;
    if (threadIdx.x == 0) (void)xb_add(&bar[XB_XCNT(b.x)], 1u);
    return b;
}
__device__ __forceinline__ void xcd_barrier_complete(unsigned* bar, unsigned x, unsigned& nloc, unsigned& nx) {
    const unsigned G = gridDim.x * gridDim.y * gridDim.z;
    unsigned sum, cnt, mine, sp = 0u;
    for (;;) {
        sum = 0u; cnt = 0u; mine = 0u;
#pragma unroll
        for (unsigned j = 0; j < 16; ++j) { const unsigned c = xb_ld(&bar[XB_XCNT(j)]); sum += c; cnt += (c > 0u) ? 1u : 0u; mine = (j == x) ? c : mine; }
        if (sum == G) break;
        __builtin_amdgcn_s_sleep(1);
        if ((++sp & 255u) == 0u) { if (xb_ld(&bar[XB_TMO])) break; if (sp > XB_SPIN_CAP) { atomicAdd(&bar[XB_TMO], 1u); break; } }
    }
    nloc = mine > 0u ? mine : 1u; nx = cnt > 0u ? cnt : 1u;
}

__device__ __forceinline__ void xcd_barrier(const XcdBarrier& b) {
    asm volatile("s_waitcnt vmcnt(0)" ::: "memory");
    __syncthreads();
    if (threadIdx.x == 0) {
        unsigned* bar = b.bar;
        __builtin_amdgcn_s_waitcnt(0);
        unsigned nloc = b.st[0], nx = b.st[1];
        if (nloc == 0u) { xcd_barrier_complete(bar, b.x, nloc, nx); b.st[0] = nloc; b.st[1] = nx; }
        const unsigned old = xb_add(&bar[XB_XSUB(b.x)], 1u);
        const unsigned gen = old / nloc;
        if (old + 1u == (gen + 1u) * nloc) {
            __builtin_amdgcn_fence(__ATOMIC_RELEASE, "agent");
            asm volatile("s_waitcnt vmcnt(0)" ::: "memory");
            const unsigned og = xb_add(&bar[XB_TOP], 1u);
            const unsigned tg = og / nx;
            if (og + 1u == (tg + 1u) * nx) xb_add(&bar[XB_TOPGEN], 1u);
            else XB_SPIN(xb_ld(&bar[XB_TOPGEN]) == tg, bar);
            __builtin_amdgcn_fence(__ATOMIC_ACQUIRE, "agent");
            xb_add(&bar[XB_XGEN(b.x)], 1u);
            asm volatile("s_waitcnt vmcnt(0)" ::: "memory");
        } else {
            XB_SPIN(xb_ld(&bar[XB_XGEN(b.x)]) == gen, bar);
            __builtin_amdgcn_fence(__ATOMIC_ACQUIRE, "agent");
            asm volatile("s_waitcnt vmcnt(0)" ::: "memory");
        }
    }
    __syncthreads();
}

#ifndef MK_LAUNCHES
#define MK_LAUNCHES 1
#endif
constexpr int N_PHASES = 12;
__global__ void __launch_bounds__(NTHR) yoco_fwd(Ptrs P) {
    extern __shared__ __attribute__((aligned(16))) unsigned char lds_raw[];
    LAS unsigned char* lds = (LAS unsigned char*)lds_raw;
    const int tid = threadIdx.x, lane = tid & 63, wave = __builtin_amdgcn_readfirstlane(tid >> 6);
    const int G = gridDim.x, bx = blockIdx.x; const int vcu = (G % 8 == 0) ? (bx % 8) * (G / 8) + bx / 8 : bx;
    unsigned char* ws = P.ws;
    bf16* XB = (bf16*)(ws + WS_XB); bf16* R1 = (bf16*)(ws + WS_R1); bf16* R2 = (bf16*)(ws + WS_R2); bf16* R3 = (bf16*)(ws + WS_R3); bf16* OB = (bf16*)(ws + WS_O);
    float* SS0 = (float*)(ws + WS_SS); float* SS1 = SS0 + (size_t)M * 16; float* SS2 = SS1 + (size_t)M * 16; float* SS3 = SS2 + (size_t)M * 16; float* SS4 = SS3 + (size_t)M * 16;
    const int lo = P.ph_lo, hi = P.ph_hi;
    volatile LAS unsigned* xst = (volatile LAS unsigned*)(lds + LDS_BYTES - 64);
    if (tid == 0) { xst[0] = 0u; xst[1] = 0u; }
    __syncthreads();
    XcdBarrier xbar = xcd_barrier_post((unsigned*)(ws + WS_BAR), xst);
    if (P.ph_lo > 1000) cg::this_grid().sync();
#define IN(k) (lo <= (k) && (k) < hi)
#if MK_LAUNCHES == 1
#define SEAM(k) do { if (IN(k) && IN((k) + 1)) { xcd_barrier(xbar); } } while (0)
#else
#define SEAM(k) do { } while (0)
#endif
    if (IN(0)) { p0_prologue(P, lds, vcu, G, wave, lane, tid); } SEAM(0);
    if (IN(1)) {
        pg8::Gemm g{XB, (const bf16*)(ws + WS_WIN), M, 2 * D, D}; pg8::StaticOrder S; S.init(M, 2 * D, G, bx);
        pg8::EpiGeluSplit E{R1, R2, SS0, 1, nullptr};
        pg8::gemm_phase<pg8::EpiGeluSplit, pg8::StaticOrder, true, true>(lds, g, S, E); } SEAM(1);
    if (IN(2)) { spatial_phase(lds, R1, R2, (const bf16*)(ws + WS_WSP), P.in[3], P.in[5], R3, vcu, G, wave, lane, tid); } SEAM(2);
    if (IN(3)) {
        pg8::Gemm g{R3, (const bf16*)(ws + WS_WOUT), M, D, D}; pg8::StaticOrder S; S.init(M, D, G, bx);
        pg8::EpiRes<false> E{XB, nullptr, SS1, (LAS float*)(lds + pg8::STAGE_BYTES)};
        pg8::gemm_phase<pg8::EpiRes<false>, pg8::StaticOrder, true, true>(lds, g, S, E); } SEAM(3);
    if (IN(4)) {
        pg8::Gemm g{XB, (const bf16*)(ws + WS_WGU0), M, 2 * FF, D}; pg8::StaticOrder S; S.init(M, 2 * FF, G, bx);
        pg8::EpiSwiglu E{R1, FF, SS1};
        pg8::gemm_phase<pg8::EpiSwiglu, pg8::StaticOrder, true, true>(lds, g, S, E); } SEAM(4);
    if (IN(5)) {
        pg8::Gemm g{R1, (const bf16*)(ws + WS_WDN0), M, D, FF}; pg8::StaticOrder S; S.init(M, D, G, bx);
        pg8::EpiRes<false> E{XB, nullptr, SS2, (LAS float*)(lds + pg8::STAGE_BYTES)};
        pg8::gemm_phase<pg8::EpiRes<false>, pg8::StaticOrder, true, true>(lds, g, S, E); } SEAM(5);
    if (IN(6)) {
        { pg8::Gemm g{XB, (const bf16*)(ws + WS_WQKV), M, 2 * D, D}; pg8::StaticOrder S; S.init(M, 2 * D, G, bx);
          pg8::EpiGeluSplit E{R1, R2, SS2, 0, (unsigned*)(ws + WS_CTL)};
          pg8::gemm_phase<pg8::EpiGeluSplit, pg8::StaticOrder, true, true>(lds, g, S, E); }
        { pg8::Gemm g{XB, (const bf16*)(ws + WS_WQKV) + (size_t)2 * D * D, M, D, D}; pg8::StaticOrder S; S.init(M, D, G, bx);
          pg8::EpiVT E{R3, SS2};
          pg8::gemm_phase<pg8::EpiVT, pg8::StaticOrder, true, true>(lds, g, S, E); } } SEAM(6);
    if (IN(7)) { attn_phase(lds, R1, R2, R3, OB, P.in[14], (const float*)(ws + WS_CTL), (unsigned*)(ws + WS_CTL + 4096), wave, lane, tid); } SEAM(7);
    if (IN(8)) {
        pg8::Gemm g{OB, (const bf16*)(ws + WS_WO), M, D, D}; pg8::StaticOrder S; S.init(M, D, G, bx);
        pg8::EpiRes<false> E{XB, nullptr, SS3, (LAS float*)(lds + pg8::STAGE_BYTES)};
        pg8::gemm_phase<pg8::EpiRes<false>, pg8::StaticOrder, true, true>(lds, g, S, E); } SEAM(8);
    if (IN(9)) {
        pg8::Gemm g{XB, (const bf16*)(ws + WS_WGU1), M, 2 * FF, D}; pg8::StaticOrder S; S.init(M, 2 * FF, G, bx);
        pg8::EpiSwiglu E{R1, FF, SS3};
        pg8::gemm_phase<pg8::EpiSwiglu, pg8::StaticOrder, true, true>(lds, g, S, E); } SEAM(9);
    if (IN(10)) {
        pg8::Gemm g{R1, (const bf16*)(ws + WS_WDN1), M, D, FF}; pg8::StaticOrder S; S.init(M, D, G, bx);
        pg8::EpiRes<false> E{XB, nullptr, SS4, (LAS float*)(lds + pg8::STAGE_BYTES)};
        pg8::gemm_phase<pg8::EpiRes<false>, pg8::StaticOrder, true, true>(lds, g, S, E); } SEAM(10);
    if (IN(11)) { final_phase(XB, P.out, SS4, P.in[17], vcu, G, wave, lane); }
#undef IN
#undef SEAM
}

extern "C" void kernel_launch(void* const* d_in, const int* in_sizes, int n_in, void* d_out, int out_size, void* d_ws, size_t ws_size, hipStream_t stream) {
    static int grid = 0;
    if (grid == 0) {
        if (n_in != 18 || in_sizes[0] != M * D || out_size != M * D || ws_size < WS_END) { fprintf(stderr, "kernel_launch: unexpected shapes (n_in %d, in0 %d, out %d, ws %zu)\n", n_in, n_in > 0 ? in_sizes[0] : -1, out_size, ws_size); grid = -1; return; }
        int dev = 0, cus = 0, per_cu = 0;
        (void)hipGetDevice(&dev); (void)hipDeviceGetAttribute(&cus, hipDeviceAttributeMultiprocessorCount, dev);
        if (hipFuncSetAttribute((const void*)yoco_fwd, hipFuncAttributeMaxDynamicSharedMemorySize, LDS_BYTES) != hipSuccess) { fprintf(stderr, "kernel_launch: hipFuncSetAttribute failed\n"); grid = -1; return; }
        if (hipOccupancyMaxActiveBlocksPerMultiprocessor(&per_cu, (const void*)yoco_fwd, NTHR, LDS_BYTES) != hipSuccess || per_cu < 1) { fprintf(stderr, "kernel_launch: occupancy query says %d\n", per_cu); per_cu = 1; }
        (void)hipGetLastError();
        grid = cus * 1;
        fprintf(stderr, "kernel_launch: grid %d (cus %d, per_cu %d)\n", grid, cus, per_cu);
    }
    if (grid < 0) return;
    Ptrs p{};
    for (int i = 0; i < 18; ++i) p.in[i] = (const float*)d_in[i];
    p.out = (float*)d_out; p.ws = (unsigned char*)d_ws;
#if MK_LAUNCHES == 1
    if (hipMemsetAsync((char*)d_ws + WS_BAR, 0, 3456 * sizeof(unsigned), stream) != hipSuccess) { fprintf(stderr, "kernel_launch: hipMemsetAsync of the barrier words failed\n"); return; }
    p.ph_lo = 0; p.ph_hi = N_PHASES;
    void* args[] = {&p};
    hipError_t e = hipLaunchCooperativeKernel((const void*)yoco_fwd, dim3(grid), dim3(NTHR), args, LDS_BYTES, stream);
    if (e != hipSuccess) fprintf(stderr, "kernel_launch: cooperative launch failed: %s (grid %d)\n", hipGetErrorString(e), grid);
#else
    for (int k = 0; k < N_PHASES; ++k) { p.ph_lo = k; p.ph_hi = k + 1; hipLaunchKernelGGL(yoco_fwd, dim3(grid), dim3(NTHR), LDS_BYTES, stream, p); }
#endif
}
```
